# Optimizing an MI355X kernel written in HIP

```python
import jax, jax.numpy as jnp
from jax import lax
import numpy as np

D_MODEL = 1024
BATCH = 8
SEQ = 4096
DEPTH = 1

CHUNK = 64
PLE_DIM = 256
GLA_HEADS = 4
GLA_DK = 128
GLA_DV = 256
GLA_GATE_RANK = 16
GLA_GATE_TAU = 16.0
GLA_QK = GLA_HEADS * GLA_DK
GLA_V = GLA_HEADS * GLA_DV
ATT_HEADS = 16
ATT_DH = 64
ATT_W = ATT_HEADS * ATT_DH
ATT_PAST_CHUNKS = 8
REL_CLIP = 256
N_EXPERTS = 32
TOP_K = 4
D_EXPERT = D_MODEL
SWIGLU_ALPHA = 1.702
SWIGLU_LIMIT = 7.0
EPS = 1e-6
IN_SPLITS = (GLA_QK, GLA_QK, GLA_V, GLA_GATE_RANK, GLA_V, ATT_W, ATT_W, ATT_W, D_MODEL, D_MODEL)
D_IN = 2 * GLA_QK + 2 * GLA_V + GLA_GATE_RANK + 3 * ATT_W + 2 * D_MODEL

kernel_name = 'hybrid_gla_bandattn_moe_ple_block'


def rmsnorm(x, g):
    xf = x.astype(jnp.float32)
    y = xf * lax.rsqrt(jnp.mean(xf * xf, axis=-1, keepdims=True) + EPS)
    return (y * g.astype(jnp.float32)).astype(x.dtype)


def gla_chunked(q, k, v, g_log):
    B, T, H, dk = q.shape
    dv = v.shape[-1]
    n = T // CHUNK

    def chunks(a):
        return a.astype(jnp.float32).reshape(B, n, CHUNK, H, a.shape[-1]).transpose(1, 0, 3, 2, 4)

    qc = chunks(q) * (dk ** -0.5)
    kc, vc, gc = chunks(k), chunks(v), chunks(g_log)
    causal = jnp.tril(jnp.ones((CHUNK, CHUNK), dtype=bool))[:, :, None]

    def step(S, inp):
        qi, ki, vi, gi = inp
        b = jnp.cumsum(gi, axis=2)
        diff = b[:, :, :, None, :] - b[:, :, None, :, :]
        decay = jnp.exp(jnp.where(causal, diff, -jnp.inf))
        scores = jnp.einsum('bhtsd,bhsd->bhts', qi[:, :, :, None, :] * decay, ki)
        o = (jnp.einsum('bhts,bhsv->bhtv', scores, vi)
             + jnp.einsum('bhtd,bhdv->bhtv', qi * jnp.exp(b), S))
        b_last = b[:, :, -1:, :]
        S = (jnp.exp(b_last[:, :, 0, :, None]) * S
             + jnp.einsum('bhsd,bhsv->bhdv', ki * jnp.exp(b_last - b), vi))
        return S, o

    S0 = jnp.zeros((B, H, dk, dv), jnp.float32)
    _, o = lax.scan(step, S0, (qc, kc, vc, gc))
    return o.transpose(1, 0, 3, 2, 4).reshape(B, T, H, dv)


def chunk_band_attention(q, k, v, rel_bias):
    B, T, H, dh = q.shape
    n = T // CHUNK
    pad = ATT_PAST_CHUNKS * CHUNK
    band = pad + CHUNK
    kp = jnp.pad(k, ((0, 0), (pad, 0), (0, 0), (0, 0)))
    vp = jnp.pad(v, ((0, 0), (pad, 0), (0, 0), (0, 0)))
    qc = q.reshape(B, n, CHUNK, H, dh).transpose(1, 0, 2, 3, 4)
    q_pos = jnp.arange(CHUNK) + pad
    k_pos = jnp.arange(band)
    rel = jnp.clip(q_pos[:, None] - k_pos[None, :], -REL_CLIP, REL_CLIP) + REL_CLIP
    bias = rel_bias.astype(jnp.float32)[:, rel]
    scale = dh ** -0.5

    def one_chunk(args):
        c, qi = args
        start = c * CHUNK
        ki = lax.dynamic_slice_in_dim(kp, start, band, axis=1)
        vi = lax.dynamic_slice_in_dim(vp, start, band, axis=1)
        s = jnp.einsum('bqhd,bkhd->bhqk', qi, ki).astype(jnp.float32) * scale + bias
        valid = (start + k_pos) >= pad
        s = jnp.where(valid[None, None, None, :], s, -jnp.inf)
        w = jax.nn.softmax(s, axis=-1)
        return jnp.einsum('bhqk,bkhd->bqhd', w.astype(vi.dtype), vi)

    o = lax.map(one_chunk, (jnp.arange(n), qc))
    return o.transpose(1, 0, 2, 3, 4).reshape(B, T, H * dh)


def clamped_swiglu(h):
    x_glu = jnp.minimum(h[..., ::2], SWIGLU_LIMIT)
    x_lin = jnp.clip(h[..., 1::2], -SWIGLU_LIMIT, SWIGLU_LIMIT)
    return x_glu * jax.nn.sigmoid(SWIGLU_ALPHA * x_glu) * (x_lin + 1.0)


def moe_ffn(x, w_router, b_router, w1, b1, w2, b2):
    logits = (x @ w_router + b_router).astype(jnp.float32)
    top_vals, top_idx = lax.top_k(logits, TOP_K)
    top_w = jax.nn.softmax(top_vals, axis=-1)
    gates = jnp.einsum('nk,nke->ne', top_w, jax.nn.one_hot(top_idx, N_EXPERTS, dtype=jnp.float32))
    out = jnp.zeros(x.shape, jnp.float32)
    for e in range(N_EXPERTS):
        h = x @ w1[e] + b1[e]
        y = clamped_swiglu(h) @ w2[e] + b2[e]
        out = out + gates[:, e:e + 1] * y.astype(jnp.float32)
    return out.astype(x.dtype)


def setup_inputs(seed: int = 0) -> dict:
    key = jax.random.key(seed)
    ks = jax.random.split(key, 20)

    def nrm(k, shape, scale):
        return jax.random.normal(k, shape, jnp.float32) * scale

    def gain(k, shape):
        return 1.0 + nrm(k, shape, 0.05)

    D, E, F = D_MODEL, N_EXPERTS, D_EXPERT
    return {
        'x': nrm(ks[0], (BATCH, SEQ, D), 1.0),
        'p': nrm(ks[1], (DEPTH, BATCH, SEQ, PLE_DIM), 1.0),
        'ln_mix': gain(ks[2], (DEPTH, D)),
        'w_in': nrm(ks[3], (DEPTH, D, D_IN), D ** -0.5),
        'w_gk': nrm(ks[4], (DEPTH, GLA_GATE_RANK, GLA_QK), GLA_GATE_RANK ** -0.5),
        'b_gk': nrm(ks[5], (DEPTH, GLA_QK), 0.1),
        'gla_norm': gain(ks[6], (DEPTH, GLA_DV)),
        'rel_bias': nrm(ks[7], (DEPTH, ATT_HEADS, 2 * REL_CLIP + 1), 0.1),
        'w_out': nrm(ks[8], (DEPTH, D, D), D ** -0.5),
        'ln_moe': gain(ks[9], (DEPTH, D)),
        'w_router': nrm(ks[10], (DEPTH, D, E), D ** -0.5),
        'b_router': nrm(ks[11], (DEPTH, E), 0.01),
        'w1': nrm(ks[12], (DEPTH, E, D, 2 * F), D ** -0.5),
        'b1': nrm(ks[13], (DEPTH, E, 2 * F), 0.01),
        'w2': nrm(ks[14], (DEPTH, E, F, D), F ** -0.5),
        'b2': nrm(ks[15], (DEPTH, E, D), 0.01),
        'ln_ple': gain(ks[16], (DEPTH, D)),
        'w_ple_gate': nrm(ks[17], (DEPTH, D, D), D ** -0.5),
        'w_ple_proj': nrm(ks[18], (DEPTH, PLE_DIM, D), PLE_DIM ** -0.5),
        'ln_final': gain(ks[19], (D,)),
    }


def reference(x, p, ln_mix, w_in, w_gk, b_gk, gla_norm, rel_bias, w_out, ln_moe, w_router,
              b_router, w1, b1, w2, b2, ln_ple, w_ple_gate, w_ple_proj, ln_final):
    B, T, D = x.shape
    splits = np.cumsum(IN_SPLITS)[:-1].tolist()
    for i in range(DEPTH):
        xn = rmsnorm(x, ln_mix[i])
        z = xn @ w_in[i]
        q_g, k_g, v_g, gk_low, r_g, q_a, k_a, v_a, gt_a, gt_b = jnp.split(z, splits, axis=-1)

        g_log = jax.nn.log_sigmoid((gk_low @ w_gk[i] + b_gk[i]).astype(jnp.float32)) / GLA_GATE_TAU
        o_g = gla_chunked(q_g.reshape(B, T, GLA_HEADS, GLA_DK),
                          k_g.reshape(B, T, GLA_HEADS, GLA_DK),
                          v_g.reshape(B, T, GLA_HEADS, GLA_DV),
                          g_log.reshape(B, T, GLA_HEADS, GLA_DK))
        o_g = rmsnorm(o_g, gla_norm[i]) * jax.nn.silu(r_g.reshape(B, T, GLA_HEADS, GLA_DV).astype(jnp.float32))
        y_a = o_g.reshape(B, T, GLA_V).astype(x.dtype)

        y_b = chunk_band_attention(q_a.reshape(B, T, ATT_HEADS, ATT_DH),
                                   k_a.reshape(B, T, ATT_HEADS, ATT_DH),
                                   v_a.reshape(B, T, ATT_HEADS, ATT_DH),
                                   rel_bias[i])

        h = jax.nn.sigmoid(gt_a) * y_a + jax.nn.sigmoid(gt_b) * y_b
        x = x + h @ w_out[i]

        xm = rmsnorm(x, ln_moe[i]).reshape(B * T, D)
        x = x + moe_ffn(xm, w_router[i], b_router[i], w1[i], b1[i], w2[i], b2[i]).reshape(B, T, D)

        ple_gate = jax.nn.sigmoid(rmsnorm(x, ln_ple[i]) @ w_ple_gate[i])
        x = x + ple_gate * (p[i] @ w_ple_proj[i])
    return rmsnorm(x, ln_final)
```

```cpp
#define MK_N_LAUNCHES 1
#include <hip/hip_runtime.h>
#include <cstdio>
#include <cstdint>

#define GAS __attribute__((address_space(1)))
#define LAS __attribute__((address_space(3)))
typedef unsigned short bf16_t;
typedef short bf16x8 __attribute__((ext_vector_type(8)));
typedef short s16x4 __attribute__((ext_vector_type(4)));
typedef float f32x4 __attribute__((ext_vector_type(4)));
typedef float f32x2 __attribute__((ext_vector_type(2)));
typedef float f32x16 __attribute__((ext_vector_type(16)));
typedef unsigned u32x4 __attribute__((ext_vector_type(4)));
typedef unsigned u32x2 __attribute__((ext_vector_type(2)));
typedef __bf16 bf16x2_t __attribute__((ext_vector_type(2)));
typedef int v8i_t __attribute__((ext_vector_type(8)));
__device__ __forceinline__ unsigned pk4_fp8(float a, float b, float c, float d) { int w = __builtin_amdgcn_cvt_pk_fp8_f32(a, b, 0, false); w = __builtin_amdgcn_cvt_pk_fp8_f32(c, d, w, true); return (unsigned)w; }

__device__ __forceinline__ unsigned pk2(float lo, float hi) { f32x2 v = {lo, hi}; bf16x2_t b = __builtin_convertvector(v, bf16x2_t); return __builtin_bit_cast(unsigned, b); }
__device__ __forceinline__ float bf_lo(unsigned w) { return __uint_as_float(w << 16); }
__device__ __forceinline__ float bf_hi(unsigned w) { return __uint_as_float(w & 0xffff0000u); }
__device__ __forceinline__ float fast_exp2(float x) { return __builtin_amdgcn_exp2f(x); }
__device__ __forceinline__ float fast_rcp(float x) { return __builtin_amdgcn_rcpf(x); }
__device__ __forceinline__ float sigmoidf_(float x) { return fast_rcp(1.0f + fast_exp2(-1.4426950408889634f * x)); }

namespace pg8 {
constexpr int BM = 256, BK = 64, HALF = 128, HTB = HALF * BK * 2, STAGE_BYTES = 8 * HTB, NXCD = 8, WGM = 8;
__host__ __device__ __forceinline__ int lds_byte(int r, int c) { const int st = (r >> 4) * 2 + (c >> 5), rr = r & 15, cc = c & 31, ob = rr * 64 + cc * 2; return st * 1024 + (ob ^ (((ob >> 9) & 1) << 5)); }
__host__ __device__ __forceinline__ void stage_rc(int b, int& R, int& C) { const int st = b / 1024, sb = b % 1024, swz = sb ^ (((sb >> 9) & 1) << 5); R = (st >> 1) * 16 + swz / 64; C = (st & 1) * 32 + (swz % 64) / 2; }
__host__ __device__ __forceinline__ int perm32(int rho) { const int n = rho >> 4, i = rho & 15; return 8 * (i >> 2) + 4 * n + (i & 3); }

struct Unit { int pm, pn; };
struct Gemm { const bf16_t* A; const bf16_t* Bt; int K; };

struct StaticOrder {
    int nM, nN, nwg, G, c;
    __device__ __forceinline__ void init(int M, int N, int G_, int c_) { nM = M / BM; nN = N / BM; nwg = nM * nN; G = G_; c = c_; }
    __device__ __forceinline__ bool next(int i, Unit& u) const {
        const long L = (long)i * G + c; if (L >= nwg) return false;
        int wgid = (int)L; { const int q = nwg / NXCD, r = nwg % NXCD, xcd = wgid % NXCD, off = wgid / NXCD; wgid = (xcd < r ? xcd * (q + 1) : r * (q + 1) + (xcd - r) * q) + off; }
        const int nig = WGM * nN, gid = wgid / nig, fm = gid * WGM, gsz = (nM - fm) < WGM ? (nM - fm) : WGM;
        u.pm = fm + ((wgid % nig) % gsz); u.pn = (wgid % nig) / gsz; return true;
    }
    __device__ __forceinline__ unsigned arow(const Unit& u, int r, int K) const { return (unsigned)((u.pm * BM + r) * K) * 2u; }
};
template <bool GATHER> struct MoeOrder {
    const int* tile_expert; const int* rowmap; int ntiles, NT, G, c;
    __device__ __forceinline__ bool next(int i, Unit& u) const {
        const int nx = G >> 3, x = c & 7, y = c >> 3, tper = (ntiles + 7) >> 3, mt0 = x * tper;
        const int q = i * nx + y, ml = q / NT, mt = mt0 + ml;
        if (ml >= tper || mt >= ntiles) return false;
        u.pm = mt; u.pn = __builtin_amdgcn_readfirstlane(tile_expert[mt]) * NT + (q - ml * NT); return true;
    }
    __device__ __forceinline__ unsigned arow(const Unit& u, int r, int K) const {
        if (GATHER) return (unsigned)(rowmap[u.pm * BM + r] * K) * 2u;
        return (unsigned)((u.pm * BM + r) * K) * 2u;
    }
};

template <class Epi, class Sched, bool FP8 = false>
__device__ __forceinline__ void gemm_phase(LAS unsigned char* lds, const Gemm g, const Sched& S, const Epi& E, int variant = 0) {
    int tid_ = threadIdx.x; asm volatile("" : "+v"(tid_));
    const int tid = tid_, wid = __builtin_amdgcn_readfirstlane(tid >> 6), lane = tid & 63, wr = wid >> 2, wc = wid & 3, fr = lane & 15, fq = lane >> 4;
    int K_ = (variant & 8) ? (g.K >> 1) : g.K; asm volatile("" : "+s"(K_));
    const int K = K_, nt = K / BK;
    int RA[2], CA[2]; unsigned voffB[2];
#pragma unroll
    for (int i = 0; i < 2; ++i) { int R, C; stage_rc(tid * 16 + i * 8192, R, C); const int Rb = Epi::PERM ? ((R & ~31) + perm32(R & 31)) : R;
        RA[i] = R; CA[i] = C * 2; voffB[i] = (unsigned)(Rb * K + C) * 2u; }
    const size_t kstep = (size_t)(BK * 2);
    const size_t hstep = (size_t)HALF * K * 2;
    const size_t tstep = 2 * hstep;
    const unsigned ldsw = (unsigned)wid * 1024u;
    const int aoff = lds_byte(wr * 64 + fr, fq * 8), boff = lds_byte(wc * 32 + fr, fq * 8);
#define PG8_SA(b, h) (((b) * 2 + (h)) * HTB)
#define PG8_SB(b, h) ((4 + (b) * 2 + (h)) * HTB)
#define PG8_STAGE(bufoff, gbase, voff) do { _Pragma("unroll") for (int _i = 0; _i < 2; ++_i) \
        __builtin_amdgcn_global_load_lds((const unsigned*)((const char*)(gbase) + (voff)[_i]), (LAS unsigned*)(lds + (bufoff) + ldsw + _i * 8192), 16, 0, 0); } while (0)
#define PG8_LDA(dst, b, h) do { _Pragma("unroll") for (int m = 0; m < 4; ++m) _Pragma("unroll") for (int k = 0; k < 2; ++k) dst[m][k] = *(const LAS bf16x8*)(lds + PG8_SA(b, h) + aoff + m * 2048 + k * 1024); } while (0)
#define PG8_LDB(dst, b, h) do { _Pragma("unroll") for (int n = 0; n < 2; ++n) _Pragma("unroll") for (int k = 0; k < 2; ++k) dst[n][k] = *(const LAS bf16x8*)(lds + PG8_SB(b, h) + boff + n * 2048 + k * 1024); } while (0)
#define PG8_CAT(a, b) __builtin_bit_cast(v8i_t, __builtin_shufflevector((a), (b), 0, 1, 2, 3, 4, 5, 6, 7, 8, 9, 10, 11, 12, 13, 14, 15))
#define PG8_MMA(ai, bj, At, Bt) do { __builtin_amdgcn_s_setprio(1); \
        if constexpr (FP8) { _Pragma("unroll") for (int m = 0; m < 4; ++m) _Pragma("unroll") for (int n = 0; n < 2; ++n) \
            acc[ai][bj][m][n] = __builtin_amdgcn_mfma_scale_f32_16x16x128_f8f6f4(PG8_CAT(Bt[n][0], Bt[n][1]), PG8_CAT(At[m][0], At[m][1]), acc[ai][bj][m][n], 0, 0, 0, 0, 0, 0);     } \
        else { _Pragma("unroll") for (int m = 0; m < 4; ++m) _Pragma("unroll") for (int n = 0; n < 2; ++n) _Pragma("unroll") for (int k = 0; k < 2; ++k) \
            acc[ai][bj][m][n] = __builtin_amdgcn_mfma_f32_16x16x32_bf16(Bt[n][k], At[m][k], acc[ai][bj][m][n], 0, 0, 0); } \
        __builtin_amdgcn_s_setprio(0); } while (0)
#define PG8_WAIT_V(n) asm volatile("s_waitcnt vmcnt(" #n ")" ::: "memory")
#define PG8_WAIT_L(n) asm volatile("s_waitcnt lgkmcnt(" #n ")" ::: "memory")
#define PG8_BAR __builtin_amdgcn_s_barrier()
#define PG8_SCHED __builtin_amdgcn_sched_barrier(0)
    Unit cur, nxt; int ui = 0;
    if (!S.next(0, cur)) return;
    f32x4 acc[2][2][4][2];
#pragma unroll
    for (int a = 0; a < 2; ++a)
#pragma unroll
        for (int b = 0; b < 2; ++b)
#pragma unroll
            for (int m = 0; m < 4; ++m)
#pragma unroll
                for (int n = 0; n < 2; ++n) acc[a][b][m][n] = (f32x4){0.f, 0.f, 0.f, 0.f};
    bf16x8 At[4][2], B0[2][2], B1[2][2];
    unsigned vA0[2], vA1[2];
#pragma unroll
    for (int i = 0; i < 2; ++i) { vA0[i] = S.arow(cur, RA[i], K) + (unsigned)CA[i]; vA1[i] = S.arow(cur, HALF + RA[i], K) + (unsigned)CA[i]; }
    const char* const Ab = (const char*)g.A;
    const char* cB = (const char*)g.Bt + (size_t)cur.pn * tstep;
    PG8_STAGE(PG8_SB(0, 0), cB, voffB); PG8_STAGE(PG8_SB(0, 1), cB + hstep, voffB); PG8_STAGE(PG8_SA(0, 0), Ab, vA0); PG8_STAGE(PG8_SA(0, 1), Ab, vA1);
    if (wr == 1) PG8_BAR;
    PG8_WAIT_V(2); PG8_BAR;
    PG8_STAGE(PG8_SB(1, 0), cB + kstep, voffB); PG8_STAGE(PG8_SA(1, 0), Ab + kstep, vA0); PG8_STAGE(PG8_SB(1, 1), cB + hstep + kstep, voffB);
    PG8_WAIT_V(6); PG8_BAR;
    for (;;) {
        const bool has_next = S.next(ui + 1, nxt);
        const char* nB = has_next ? (const char*)g.Bt + (size_t)nxt.pn * tstep : cB;
        for (int t = 0; t < nt; t += 2) {
            const bool last = (t == nt - 2);
            const char* a1 = Ab + (size_t)(t + 1) * kstep;
            const char* a2 = last ? Ab : Ab + (size_t)(t + 2) * kstep; const char* b2 = last ? nB : cB + (size_t)(t + 2) * kstep;
            const char* a3 = a2 + kstep; const char* b3 = b2 + kstep;
            PG8_LDB(B0, 0, 0); PG8_LDB(B1, 0, 1); PG8_SCHED; PG8_LDA(At, 0, 0); PG8_STAGE(PG8_SA(1, 1), a1, vA1);
            if (last && has_next) {
#pragma unroll
                for (int i = 0; i < 2; ++i) { vA0[i] = S.arow(nxt, RA[i], K) + (unsigned)CA[i]; vA1[i] = S.arow(nxt, HALF + RA[i], K) + (unsigned)CA[i]; }
            }
            PG8_WAIT_V(8); PG8_WAIT_L(0); PG8_BAR; PG8_MMA(0, 0, At, B0); PG8_MMA(0, 1, At, B1); PG8_BAR; PG8_SCHED;
            PG8_LDA(At, 0, 1); PG8_STAGE(PG8_SB(0, 0), b2, voffB); PG8_STAGE(PG8_SB(0, 1), b2 + hstep, voffB); PG8_STAGE(PG8_SA(0, 0), a2, vA0);
            PG8_WAIT_V(8); PG8_WAIT_L(0); PG8_BAR; PG8_MMA(1, 0, At, B0); PG8_MMA(1, 1, At, B1); PG8_BAR; PG8_SCHED;
            PG8_LDB(B0, 1, 0); PG8_LDB(B1, 1, 1); PG8_SCHED; PG8_LDA(At, 1, 0); PG8_STAGE(PG8_SA(0, 1), a2, vA1);
            PG8_WAIT_V(8); PG8_WAIT_L(0); PG8_BAR; PG8_MMA(0, 0, At, B0); PG8_MMA(0, 1, At, B1); PG8_BAR; PG8_SCHED;
            PG8_LDA(At, 1, 1); PG8_STAGE(PG8_SB(1, 0), b3, voffB); PG8_STAGE(PG8_SB(1, 1), b3 + hstep, voffB); PG8_STAGE(PG8_SA(1, 0), a3, vA0);
            PG8_WAIT_V(8); PG8_WAIT_L(0); PG8_BAR; PG8_MMA(1, 0, At, B0); PG8_MMA(1, 1, At, B1); PG8_BAR; PG8_SCHED;
        }
        if (wr == 0) PG8_BAR;
        if (!(variant & 16)) E(acc, cur, wr, wc, fr, fq);
        if (!has_next) break;
#pragma unroll
        for (int a = 0; a < 2; ++a)
#pragma unroll
            for (int b = 0; b < 2; ++b)
#pragma unroll
                for (int m = 0; m < 4; ++m)
#pragma unroll
                    for (int n = 0; n < 2; ++n) acc[a][b][m][n] = (f32x4){0.f, 0.f, 0.f, 0.f};
        cur = nxt; cB = nB; ++ui;
        if (wr == 1) PG8_BAR;
    }
    PG8_WAIT_V(0);
    PG8_BAR;
#undef PG8_SA
#undef PG8_SB
#undef PG8_STAGE
#undef PG8_LDA
#undef PG8_LDB
#undef PG8_MMA
#undef PG8_CAT
#undef PG8_WAIT_V
#undef PG8_WAIT_L
#undef PG8_BAR
#undef PG8_SCHED
}
}
constexpr int NB = 8, TSEQ = 4096, NTOK = NB * TSEQ, D = 1024, NCH = 64;
constexpr int NEXP = 32, NSLOT = NTOK * 4 + NEXP * 256;
constexpr float EPS = 1e-6f;
constexpr float LOG2E = 1.4426950408889634f;
constexpr int NWAVES = 8;
constexpr float WSCALE = 64.0f, ASCALE = 4.0f, YSCALE = 16.0f;

constexpr size_t MiB = 1u << 20, KiB = 1u << 10;
constexpr size_t WS_CTL = 0, CTL_ZERO_BYTES = 1 * MiB;
constexpr size_t WS_WIN = 2 * MiB;
constexpr size_t WS_WOUT = 19 * MiB, WS_WPG = 21 * MiB, WS_WPP = 23 * MiB;
constexpr size_t WS_WRH = 23 * MiB + 512 * KiB, WS_WRL = WS_WRH + 64 * KiB, WS_B1P = 23 * MiB + 768 * KiB;
constexpr size_t WS_W1 = 24 * MiB, WS_W2 = 152 * MiB;
constexpr size_t WS_XN = 216 * MiB;
constexpr size_t WS_OG = WS_XN;
constexpr size_t WS_X2B = WS_XN;
constexpr size_t WS_PP = 280 * MiB;
constexpr size_t WS_X1B = 344 * MiB;
constexpr size_t WS_PB = 408 * MiB;
constexpr size_t WS_SSP = WS_PB;
constexpr size_t WS_RT = 424 * MiB;
constexpr size_t WS_Z512 = 432 * MiB;
constexpr size_t WS_Z1024 = 528 * MiB;
constexpr size_t WS_VT = 848 * MiB;
constexpr size_t WS_KTT = 976 * MiB;
constexpr size_t WS_OGSS = 1008 * MiB;
constexpr size_t WS_DL = 1016 * MiB;
constexpr size_t WS_END = 1018 * MiB;
constexpr size_t WS_H = WS_Z512;
constexpr size_t WS_ACT = 432 * MiB;
constexpr size_t WS_YS = 704 * MiB;
static_assert(WS_ACT + (size_t)NSLOT * 2048 <= WS_YS && WS_YS + (size_t)NSLOT * 2048 <= WS_KTT, "MoE overlays");
constexpr size_t RT_TOPI = 0, RT_TOPW = 512 * KiB, RT_RSTD1 = 1 * MiB, RT_CNT = 1 * MiB + 128 * KiB;
constexpr size_t RT_TOKSLOT = 2 * MiB, RT_GATESLOT = 3 * MiB, RT_RSTDSLOT = 4 * MiB, RT_SLOTTOK = 5 * MiB, RT_TILEEXP = 6 * MiB, RT_NTILES = 6 * MiB + 8 * KiB, RT_RSTD2 = 6 * MiB + 64 * KiB;
constexpr int CW_TMO = 0, CW_CODE = 1, CW_BAR = 4096;

constexpr int RING_BYTES = 131072, ATT_BT_OFF = 131072, MISC_OFF = 131072 + 24576, LDS_BYTES = 131072 + 24576 + 512;

#define RLX_AGENT __ATOMIC_RELAXED, __HIP_MEMORY_SCOPE_AGENT

#define XB_TMO      128
#define XB_XCNT(j)  (256  + 64 * (j))
#define XB_XSUB(j)  (1280 + 64 * (j))
#define XB_XGEN(j)  (2304 + 64 * (j))
#define XB_TOP      3328
#define XB_TOPGEN   3392
#define XCD_BAR_WORDS 3456
#define XB_SPIN_CAP (1u << 18)
__device__ __forceinline__ unsigned xb_ld(unsigned* p)              { return __hip_atomic_load(p, __ATOMIC_RELAXED, __HIP_MEMORY_SCOPE_AGENT); }
__device__ __forceinline__ unsigned xb_add(unsigned* p, unsigned v) { return __hip_atomic_fetch_add(p, v, __ATOMIC_RELAXED, __HIP_MEMORY_SCOPE_AGENT); }
__device__ __forceinline__ unsigned xb_xcc_id() { return (unsigned)__builtin_amdgcn_s_getreg((3 << 11) | 20) & 0xFu; }
#define XB_SPIN(cond, bar) do { unsigned _sp = 0; while (cond) { __builtin_amdgcn_s_sleep(1); \
    if ((++_sp & 255u) == 0u) { if (xb_ld(&(bar)[XB_TMO])) break; if (_sp > XB_SPIN_CAP) { atomicAdd(&(bar)[XB_TMO], 1u); break; } } } } while (0)
struct XcdBarrier { unsigned* bar; unsigned x; volatile LAS unsigned* st; };
__device__ __forceinline__ XcdBarrier xcd_barrier_post(unsigned* bar, volatile LAS unsigned* st) {
    XcdBarrier b; b.bar = bar; b.x = xb_xcc_id(); b.st = st;
    if (threadIdx.x == 0) (void)xb_add(&bar[XB_XCNT(b.x)], 1u);
    return b;
}
__device__ __forceinline__ void xcd_barrier_complete(unsigned* bar, unsigned x, unsigned& nloc, unsigned& nx) {
    const unsigned G = gridDim.x * gridDim.y * gridDim.z;
    unsigned sum, cnt, mine, sp = 0u;
    for (;;) {
        sum = 0u; cnt = 0u; mine = 0u;
#pragma unroll
        for (unsigned j = 0; j < 16; ++j) { const unsigned c = xb_ld(&bar[XB_XCNT(j)]); sum += c; cnt += (c > 0u) ? 1u : 0u; mine = (j == x) ? c : mine; }
        if (sum == G) break;
        __builtin_amdgcn_s_sleep(1);
        if ((++sp & 255u) == 0u) { if (xb_ld(&bar[XB_TMO])) break; if (sp > XB_SPIN_CAP) { atomicAdd(&bar[XB_TMO], 1u); break; } }
    }
    nloc = mine > 0u ? mine : 1u; nx = cnt > 0u ? cnt : 1u;
}
__device__ __forceinline__ void xcd_barrier(const XcdBarrier& b) {
    asm volatile("s_waitcnt vmcnt(0)" ::: "memory");
    __syncthreads();
    if (threadIdx.x == 0) {
        unsigned* bar = b.bar;
        __builtin_amdgcn_s_waitcnt(0);
        unsigned nloc = b.st[0], nx = b.st[1];
        if (nloc == 0u) { xcd_barrier_complete(bar, b.x, nloc, nx); b.st[0] = nloc; b.st[1] = nx; }
        const unsigned old = xb_add(&bar[XB_XSUB(b.x)], 1u);
        const unsigned gen = old / nloc;
        if (old + 1u == (gen + 1u) * nloc) {
            __builtin_amdgcn_fence(__ATOMIC_RELEASE, "agent");
            asm volatile("s_waitcnt vmcnt(0)" ::: "memory");
            const unsigned og = xb_add(&bar[XB_TOP], 1u);
            const unsigned tg = og / nx;
            if (og + 1u == (tg + 1u) * nx) xb_add(&bar[XB_TOPGEN], 1u);
            else XB_SPIN(xb_ld(&bar[XB_TOPGEN]) == tg, bar);
            __builtin_amdgcn_fence(__ATOMIC_ACQUIRE, "agent");
            xb_add(&bar[XB_XGEN(b.x)], 1u);
            asm volatile("s_waitcnt vmcnt(0)" ::: "memory");
        } else {
            XB_SPIN(xb_ld(&bar[XB_XGEN(b.x)]) == gen, bar);
            __builtin_amdgcn_fence(__ATOMIC_ACQUIRE, "agent");
            asm volatile("s_waitcnt vmcnt(0)" ::: "memory");
        }
    }
    __syncthreads();
}

__device__ __forceinline__ float wave_sum(float v) {
#pragma unroll
    for (int o = 1; o < 64; o <<= 1) v += __shfl_xor(v, o);
    return v;
}
#define MFMA16(a, b, c) __builtin_amdgcn_mfma_f32_16x16x32_bf16((a), (b), (c), 0, 0, 0)
#define MFMA32(a, b, c) __builtin_amdgcn_mfma_f32_32x32x16_bf16((a), (b), (c), 0, 0, 0)
struct TJob { const float* W; bf16_t* WT; const float* gain; float scale; int ldw, Kd, nblk, kblk, scol, dbase, mode, start, nbatch; long sstride, dstride; };
constexpr int NJOBS = 14;
__device__ __forceinline__ int tj_drow(int mode, int dbase, int n) { if (!(mode & 1)) return dbase + n; const int f = n >> 1, s = n & 1; return 256 * (f >> 7) + 128 * s + (f & 127); }
struct TRegs { f32x4 a[8], b[8]; };
__device__ __forceinline__ void tj_decode(const LAS TJob* jobs, int it, const float*& W, bf16_t*& WT, const float*& gain, float& scale, int& ldw, int& Kd, int& k0, int& n0, int& scol, int& dbase, int& mode) {
    int j = 0;
#pragma unroll 1
    for (int q = 1; q < NJOBS; ++q) if (it >= jobs[q].start) j = q;
    const LAS TJob& J = jobs[j]; int local = it - J.start; const int per = J.nblk * J.kblk; const int bt = local / per; local -= bt * per; const int kb = local / J.nblk, nb = local - kb * J.nblk;
    W = J.W + bt * J.sstride; WT = (bf16_t*)((char*)J.WT + bt * J.dstride); gain = J.gain; scale = J.scale; ldw = J.ldw; Kd = J.Kd; k0 = 64 * kb; n0 = 64 * nb; scol = J.scol; dbase = J.dbase; mode = J.mode;
}
#define TJ_LOAD(R, W, ldw, k0, scolx, lane, mode) do { const int rp_ = (lane) >> 4, c4_ = (lane) & 15; \
    _Pragma("unroll") for (int i = 0; i < 8; ++i) { const int P_ = ((mode) & 2) ? (8 * (i >> 1) + 2 * rp_ + (i & 1)) : (4 * i + rp_); const float* s_ = (W) + (size_t)((k0) + 2 * P_) * (ldw) + (scolx) + 4 * c4_; (R).a[i] = *(const f32x4*)s_; (R).b[i] = *(const f32x4*)(s_ + (ldw)); } } while (0)
__device__ __forceinline__ void tj_process(const TRegs& R, bf16_t* WT, int Kd, const float* gain, float scale, int k0, int n0, int dbase, int mode, LAS unsigned* scr, int lane) {
    const int rp = lane >> 4, c4 = lane & 15;
    if (mode & 2) {
        const int swz = 4 * (c4 & 3);
#pragma unroll
        for (int u = 0; u < 4; ++u) { const int Q = 4 * u + rp; float g0 = scale, g1 = scale, g2 = scale, g3 = scale;
            if (gain) { const f32x4 gv = *(const f32x4*)(gain + k0 + 4 * Q); g0 *= gv[0]; g1 *= gv[1]; g2 *= gv[2]; g3 *= gv[3]; }
#pragma unroll
            for (int t = 0; t < 4; ++t) scr[(4 * c4 + t) * 16 + (Q ^ swz)] = pk4_fp8(R.a[2 * u][t] * g0, R.b[2 * u][t] * g1, R.a[2 * u + 1][t] * g2, R.b[2 * u + 1][t] * g3); }
        asm volatile("s_waitcnt lgkmcnt(0)" ::: "memory");
#pragma unroll
        for (int j = 0; j < 4; ++j) { const int n = (lane >> 2) + 16 * j, ch = lane & 3; const u32x4 v = *(const LAS u32x4*)(scr + n * 16 + ((4 * ch) ^ (4 * ((n >> 2) & 3))));
            *(u32x4*)((char*)WT + (size_t)tj_drow(mode, dbase, n0 + n) * Kd + k0 + 16 * ch) = v; }
        asm volatile("s_waitcnt lgkmcnt(0)" ::: "memory");
        return;
    }
    const int swz = 4 * (c4 & 7);
#pragma unroll
    for (int i = 0; i < 8; ++i) { const int P = 4 * i + rp; float g0 = scale, g1 = scale; if (gain) { g0 *= gain[k0 + 2 * P]; g1 *= gain[k0 + 2 * P + 1]; }
#pragma unroll
        for (int t = 0; t < 4; ++t) scr[(4 * c4 + t) * 32 + (P ^ swz)] = pk2(R.a[i][t] * g0, R.b[i][t] * g1); }
    asm volatile("s_waitcnt lgkmcnt(0)" ::: "memory");
#pragma unroll
    for (int j = 0; j < 8; ++j) { const int n = (lane >> 3) + 8 * j, ch = lane & 7; const u32x4 v = *(const LAS u32x4*)(scr + n * 32 + ((4 * ch) ^ (4 * ((n >> 2) & 7))));
        *(u32x4*)(WT + (size_t)tj_drow(mode, dbase, n0 + n) * Kd + k0 + 8 * ch) = v; }
    asm volatile("s_waitcnt lgkmcnt(0)" ::: "memory");
}

struct P0Args { const float *x, *p, *ln_mix, *w_in, *w_gk, *w_out, *ln_moe, *w_router, *w1, *b1, *w2, *ln_ple, *w_pg, *w_pp; unsigned char* ws; };

__device__ __forceinline__ void p0_prologue(const P0Args& a, LAS unsigned char* lds, int tid, int G, int vcu) {
    const int lane = tid & 63, wave = __builtin_amdgcn_readfirstlane(tid >> 6);
    LAS unsigned* scr = (LAS unsigned*)(lds + wave * 8192);
    LAS TJob* jobs = (LAS TJob*)(lds + 65536);
    const int gw = vcu * NWAVES + wave, NGW = G * NWAVES;
    bf16_t* WIN = (bf16_t*)(a.ws + WS_WIN);
    constexpr int DIN = 8208;
    const float C2 = 0.125f * LOG2E, QGS = 0.08838834764831845f;
    if (tid == 0) {
        int st = 0;
        auto add = [&](int j, const float* W, bf16_t* WT, const float* gain, float scale, int ldw, int Kd, int ncols, int Krows, int scol, int dbase, int mode, int nbatch, long ss, long ds) {
            LAS TJob* J = jobs + j; J->W = W; J->WT = WT; J->gain = gain; J->scale = scale; J->ldw = ldw; J->Kd = Kd; J->nblk = ncols / 64; J->kblk = Krows / 64; J->scol = scol; J->dbase = dbase; J->mode = mode; J->start = st; J->nbatch = nbatch; J->sstride = ss; J->dstride = ds;
            st += (ncols / 64) * (Krows / 64) * nbatch; };
        add(0, a.w1, (bf16_t*)(a.ws + WS_W1), a.ln_moe, WSCALE, 2048, D, 2048, D, 0, 0, 3, NEXP, (long)D * 2048, (long)2048 * D);
        add(1, a.w2, (bf16_t*)(a.ws + WS_W2), nullptr, WSCALE, D, D, D, D, 0, 0, 2, NEXP, (long)D * D, (long)D * D);
        add(2, a.w_in, WIN, a.ln_mix, QGS, DIN, D, 512, D, 0, 0, 0, 1, 0, 0);
        add(3, a.w_in, WIN, a.ln_mix, 1.f, DIN, D, 512, D, 512, 512, 0, 1, 0, 0);
        add(4, a.w_in, WIN, a.ln_mix, 1.f, DIN, D, 1024, D, 2064, 1536, 0, 1, 0, 0);
        add(5, a.w_in, WIN, a.ln_mix, C2, DIN, D, 1024, D, 3088, 2560, 0, 1, 0, 0);
        add(6, a.w_in, WIN, a.ln_mix, 1.f, DIN, D, 1024, D, 4112, 3584, 0, 1, 0, 0);
        add(7, a.w_in, WIN, a.ln_mix, 1.f, DIN, D, 1024, D, 6160, 4608, 0, 1, 0, 0);
        add(8, a.w_in, WIN, a.ln_mix, 1.f, DIN, D, 1024, D, 7184, 5632, 0, 1, 0, 0);
        add(9, a.w_in, WIN, a.ln_mix, 1.f, DIN, D, 1024, D, 1024, 6656, 0, 1, 0, 0);
        add(10, a.w_in, WIN, a.ln_mix, 1.f, DIN, D, 1024, D, 5136, 7680, 0, 1, 0, 0);
        add(11, a.w_out, (bf16_t*)(a.ws + WS_WOUT), nullptr, 1.f, D, D, D, D, 0, 0, 0, 1, 0, 0);
        add(12, a.w_pg, (bf16_t*)(a.ws + WS_WPG), a.ln_ple, WSCALE, D, D, D, D, 0, 0, 2, 1, 0, 0);
        add(13, a.w_pp, (bf16_t*)(a.ws + WS_WPP), nullptr, 1.f, D, 256, D, 256, 0, 0, 0, 1, 0, 0);
        *(LAS int*)(lds + 65536 + 2048) = st;
    }
    __syncthreads();
    const int nitems = *(LAS int*)(lds + 65536 + 2048);
    {
        TRegs RA, RB; const float *Wa, *ga, *Wb, *gb; bf16_t *Ta, *Tb; float sa, sb; int la, Ka, k0a, n0a, sca, dba, ma, lb, Kb, k0b, n0b, scb, dbb, mb;
        int it = gw;
        if (it < nitems) { tj_decode(jobs, it, Wa, Ta, ga, sa, la, Ka, k0a, n0a, sca, dba, ma); TJ_LOAD(RA, Wa, la, k0a, sca + n0a, lane, ma); }
        while (it < nitems) {
            int nx = it + NGW;
            if (nx < nitems) { tj_decode(jobs, nx, Wb, Tb, gb, sb, lb, Kb, k0b, n0b, scb, dbb, mb); TJ_LOAD(RB, Wb, lb, k0b, scb + n0b, lane, mb); }
            tj_process(RA, Ta, Ka, ga, sa, k0a, n0a, dba, ma, scr, lane);
            it = nx; if (it >= nitems) break;
            nx = it + NGW;
            if (nx < nitems) { tj_decode(jobs, nx, Wa, Ta, ga, sa, la, Ka, k0a, n0a, sca, dba, ma); TJ_LOAD(RA, Wa, la, k0a, sca + n0a, lane, ma); }
            tj_process(RB, Tb, Kb, gb, sb, k0b, n0b, dbb, mb, scr, lane);
            it = nx;
        }
    }
    const int gt = vcu * (NWAVES * 64) + tid, NGT = G * NWAVES * 64;
    for (int idx = gt; idx < 512 * D; idx += NGT) { const int n = idx >> 10, k = idx & 1023; const float* wr = a.w_in + (size_t)k * DIN + 2048; float s = 0.f;
#pragma unroll
        for (int r = 0; r < 16; ++r) s += wr[r] * a.w_gk[r * 512 + n];
        WIN[(size_t)(1024 + n) * D + k] = (bf16_t)(pk2(s * a.ln_mix[k], 0.f) & 0xffffu); }
    { bf16_t* WRH = (bf16_t*)(a.ws + WS_WRH); bf16_t* WRL = (bf16_t*)(a.ws + WS_WRL);
      for (int idx = gt; idx < NEXP * D; idx += NGT) { const int e = idx >> 10, k = idx & 1023; const float v = a.w_router[k * NEXP + e] * a.ln_moe[k];
          const unsigned h = pk2(v, 0.f) & 0xffffu; const float lo = v - __uint_as_float(h << 16); WRH[idx] = (bf16_t)h; WRL[idx] = (bf16_t)(pk2(lo, 0.f) & 0xffffu); } }
    { float* B1P = (float*)(a.ws + WS_B1P);
      for (int idx = gt; idx < NEXP * 2048; idx += NGT) { const int e = idx >> 11, r = idx & 2047, t = r >> 8, s = (r >> 7) & 1, j = r & 127; B1P[idx] = a.b1[e * 2048 + 2 * (128 * t + j) + s]; } }
    { bf16_t* XN = (bf16_t*)(a.ws + WS_XN);
      for (int m = gw; m < NTOK; m += 2 * NGW) { const int m2 = m + NGW; const bool has2 = m2 < NTOK;
          const f32x4* xr = (const f32x4*)(a.x + (size_t)m * D) + lane; const f32x4* xr2 = (const f32x4*)(a.x + (size_t)(has2 ? m2 : m) * D) + lane; f32x4 v[4], w[4]; float s = 0.f, s2 = 0.f;
#pragma unroll
          for (int j = 0; j < 4; ++j) { v[j] = xr[64 * j]; w[j] = xr2[64 * j]; }
#pragma unroll
          for (int j = 0; j < 4; ++j) { s += (v[j].x * v[j].x + v[j].y * v[j].y) + (v[j].z * v[j].z + v[j].w * v[j].w); s2 += (w[j].x * w[j].x + w[j].y * w[j].y) + (w[j].z * w[j].z + w[j].w * w[j].w); }
          const float rstd = 1.0f / sqrtf(wave_sum(s) * (1.f / D) + EPS), rstd2 = 1.0f / sqrtf(wave_sum(s2) * (1.f / D) + EPS);
          u32x2* o8 = (u32x2*)(XN + (size_t)m * D) + lane;
#pragma unroll
          for (int j = 0; j < 4; ++j) o8[64 * j] = (u32x2){pk2(v[j].x * rstd, v[j].y * rstd), pk2(v[j].z * rstd, v[j].w * rstd)};
          if (has2) { u32x2* o9 = (u32x2*)(XN + (size_t)m2 * D) + lane;
#pragma unroll
              for (int j = 0; j < 4; ++j) o9[64 * j] = (u32x2){pk2(w[j].x * rstd2, w[j].y * rstd2), pk2(w[j].z * rstd2, w[j].w * rstd2)}; } } }
    { u32x2* PB = (u32x2*)(a.ws + WS_PB); const f32x4* p4 = (const f32x4*)a.p;
      for (int i = gt; i < NTOK * 256 / 4; i += NGT) { const f32x4 v = p4[i]; PB[i] = (u32x2){pk2(v.x, v.y), pk2(v.z, v.w)}; } }
}

struct EpiZ {
    static constexpr bool PERM = true;
    bf16_t* z512; bf16_t* z1024; int rowmask;
    __device__ __forceinline__ void operator()(const f32x4 (&acc)[2][2][4][2], const pg8::Unit& u, int wr, int wc, int fr, int fq) const {
        bf16_t* base; int ld, colt;
        if (u.pn < 6) { base = z512 + (size_t)(u.pn >> 1) * ((size_t)NTOK * 512); ld = 512; colt = (u.pn & 1) * 256; }
        else { const int q = u.pn - 6; base = z1024 + (size_t)(q >> 2) * ((size_t)NTOK * 1024); ld = 1024; colt = (q & 3) * 256; }
        const int row0 = (u.pm * 256 + wr * 64 + fr) & rowmask, col0 = colt + wc * 32 + 8 * fq;
#pragma unroll
        for (int ai = 0; ai < 2; ++ai)
#pragma unroll
            for (int m = 0; m < 4; ++m) { bf16_t* rowp = base + (size_t)(row0 + ai * 128 + m * 16) * ld + col0;
#pragma unroll
                for (int bj = 0; bj < 2; ++bj) { const f32x4 v0 = acc[ai][bj][m][0], v1 = acc[ai][bj][m][1];
                    __builtin_nontemporal_store(((u32x4){pk2(v0[0], v0[1]), pk2(v0[2], v0[3]), pk2(v1[0], v1[1]), pk2(v1[2], v1[3])}), (u32x4*)(rowp + bj * 128)); } }
    }
};
struct EpiB {
    static constexpr bool PERM = true;
    bf16_t* O; int ldc;
    __device__ __forceinline__ void operator()(const f32x4 (&acc)[2][2][4][2], const pg8::Unit& u, int wr, int wc, int fr, int fq) const {
        const int row0 = u.pm * 256 + wr * 64 + fr, col0 = u.pn * 256 + wc * 32 + 8 * fq;
#pragma unroll
        for (int ai = 0; ai < 2; ++ai)
#pragma unroll
            for (int m = 0; m < 4; ++m) { bf16_t* rowp = O + (size_t)(row0 + ai * 128 + m * 16) * ldc + col0;
#pragma unroll
                for (int bj = 0; bj < 2; ++bj) { const f32x4 v0 = acc[ai][bj][m][0], v1 = acc[ai][bj][m][1];
                    *(u32x4*)(rowp + bj * 128) = (u32x4){pk2(v0[0], v0[1]), pk2(v0[2], v0[3]), pk2(v1[0], v1[1]), pk2(v1[2], v1[3])}; } }
    }
};
struct EpiVT {
    static constexpr bool PERM = true;
    bf16_t* O;
    __device__ __forceinline__ void operator()(const f32x4 (&acc)[2][2][4][2], const pg8::Unit& u, int wr, int wc, int fr, int fq) const {
        const int row0 = u.pm * 256 + wr * 64 + fr, col0 = u.pn * 256 + wc * 32 + 8 * fq;
        const unsigned off0 = (unsigned)((((col0 >> 6) * 2048 + row0) * 64 + (col0 & 63)) * 2);
        char* const base = (char*)O;
#pragma unroll
        for (int ai = 0; ai < 2; ++ai)
#pragma unroll
            for (int m = 0; m < 4; ++m) {
#pragma unroll
                for (int bj = 0; bj < 2; ++bj) { const f32x4 v0 = acc[ai][bj][m][0], v1 = acc[ai][bj][m][1];
                    __builtin_nontemporal_store(((u32x4){pk2(v0[0], v0[1]), pk2(v0[2], v0[3]), pk2(v1[0], v1[1]), pk2(v1[2], v1[3])}), (u32x4*)(base + (off0 + (unsigned)((ai * 128 + m * 16) * 128 + bj * 524288)))); }
                asm volatile("" ::: "memory"); }
    }
};
struct EpiX1 {
    static constexpr bool PERM = false;
    const float* x; float* out; unsigned char* xb;
    __device__ __forceinline__ void operator()(const f32x4 (&acc)[2][2][4][2], const pg8::Unit& u, int wr, int wc, int fr, int fq) const {
        const int row0 = u.pm * 256 + wr * 64 + fr, col0 = u.pn * 256 + wc * 32 + 4 * fq;
#pragma unroll
        for (int ai = 0; ai < 2; ++ai) {
            f32x4 xv[4][2][2];
#pragma unroll
            for (int m = 0; m < 4; ++m)
#pragma unroll
                for (int bj = 0; bj < 2; ++bj)
#pragma unroll
                    for (int n = 0; n < 2; ++n) xv[m][bj][n] = *(const f32x4*)(x + (size_t)(row0 + ai * 128 + m * 16) * D + col0 + bj * 128 + n * 16);
#pragma unroll
            for (int m = 0; m < 4; ++m) { const size_t ro = (size_t)(row0 + ai * 128 + m * 16) * D + col0;
#pragma unroll
                for (int bj = 0; bj < 2; ++bj)
#pragma unroll
                    for (int n = 0; n < 2; ++n) { const size_t o = ro + bj * 128 + n * 16; const f32x4 v = xv[m][bj][n] + acc[ai][bj][m][n];
                        *(f32x4*)(out + o) = v; *(unsigned*)(xb + o) = pk4_fp8(v[0], v[1], v[2], v[3]); } }
            asm volatile("" ::: "memory"); }
    }
};
struct EpiSwiglu {
    static constexpr bool PERM = true;
    const float* rstd_slot; const float* b1p; unsigned char* act;
    __device__ __forceinline__ void operator()(const f32x4 (&acc)[2][2][4][2], const pg8::Unit& u, int wr, int wc, int fr, int fq) const {
        const int e = u.pn >> 3, pnl = u.pn & 7; const int row0 = u.pm * 256 + wr * 64 + fr, j0 = wc * 32 + 8 * fq;
        const float* bb = b1p + e * 2048 + pnl * 256 + j0;
        const f32x4 bg0 = *(const f32x4*)(bb), bg1 = *(const f32x4*)(bb + 4), bl0 = *(const f32x4*)(bb + 128), bl1 = *(const f32x4*)(bb + 132);
        float rsv[2][4];
#pragma unroll
        for (int ai = 0; ai < 2; ++ai)
#pragma unroll
            for (int m = 0; m < 4; ++m) rsv[ai][m] = rstd_slot[row0 + ai * 128 + m * 16] * (1.0f / WSCALE);
#pragma unroll
        for (int ai = 0; ai < 2; ++ai)
#pragma unroll
            for (int m = 0; m < 4; ++m) { const int row = row0 + ai * 128 + m * 16; const float rs = rsv[ai][m];
                unsigned w[2];
#pragma unroll
                for (int n = 0; n < 2; ++n) { const f32x4 g4 = acc[ai][0][m][n] * rs + (n ? bg1 : bg0), l4 = acc[ai][1][m][n] * rs + (n ? bl1 : bl0); float r[4];
#pragma unroll
                    for (int i = 0; i < 4; ++i) { const float xg = fminf(g4[i], 7.0f), xl = __builtin_amdgcn_fmed3f(l4[i], -7.0f, 7.0f);
                        const float den = 1.0f + fast_exp2(xg * (-1.702f * LOG2E));
                        r[i] = xg * (xl * ASCALE + ASCALE) * fast_rcp(den); }
                    w[n] = pk4_fp8(r[0], r[1], r[2], r[3]); }
                __builtin_nontemporal_store(((u32x2){w[0], w[1]}), (u32x2*)(act + (size_t)row * D + pnl * 128 + j0)); }
    }
};
struct EpiY {
    static constexpr bool PERM = true;
    const float* gate_slot; const float* b2; unsigned char* ys;
    __device__ __forceinline__ void operator()(const f32x4 (&acc)[2][2][4][2], const pg8::Unit& u, int wr, int wc, int fr, int fq) const {
        const int e = u.pn >> 2, pnl = u.pn & 3; const int row0 = u.pm * 256 + wr * 64 + fr, col0 = pnl * 256 + wc * 32 + 8 * fq;
        f32x4 bv[2][2];
#pragma unroll
        for (int bj = 0; bj < 2; ++bj)
#pragma unroll
            for (int n = 0; n < 2; ++n) bv[bj][n] = *(const f32x4*)(b2 + e * D + col0 + bj * 128 + 4 * n);
        float gtv[2][4];
#pragma unroll
        for (int ai = 0; ai < 2; ++ai)
#pragma unroll
            for (int m = 0; m < 4; ++m) gtv[ai][m] = gate_slot[row0 + ai * 128 + m * 16];
#pragma unroll
        for (int ai = 0; ai < 2; ++ai)
#pragma unroll
            for (int m = 0; m < 4; ++m) { const int row = row0 + ai * 128 + m * 16; const float gt = gtv[ai][m] * YSCALE; unsigned char* rowp = ys + (size_t)row * D + col0;
#pragma unroll
                for (int bj = 0; bj < 2; ++bj) { const f32x4 v0 = (acc[ai][bj][m][0] * (1.0f / (WSCALE * ASCALE)) + bv[bj][0]) * gt, v1 = (acc[ai][bj][m][1] * (1.0f / (WSCALE * ASCALE)) + bv[bj][1]) * gt;
                    __builtin_nontemporal_store(((u32x2){pk4_fp8(v0[0], v0[1], v0[2], v0[3]), pk4_fp8(v1[0], v1[1], v1[2], v1[3])}), (u32x2*)(rowp + bj * 128)); } }
    }
};
struct EpiPle {
    static constexpr bool PERM = false;
    bf16_t* xb; const bf16_t* pp; const float* rstd2; float* ssp;
    __device__ __forceinline__ void operator()(const f32x4 (&acc)[2][2][4][2], const pg8::Unit& u, int wr, int wc, int fr, int fq) const {
        const int row0 = u.pm * 256 + wr * 64 + fr, col0 = u.pn * 256 + wc * 32 + 4 * fq;
#pragma unroll
        for (int ai = 0; ai < 2; ++ai) {
            u32x2 xw[4][2][2], pw[4][2][2]; float rsv[4];
#pragma unroll
            for (int m = 0; m < 4; ++m) { rsv[m] = rstd2[row0 + ai * 128 + m * 16];
#pragma unroll
                for (int bj = 0; bj < 2; ++bj)
#pragma unroll
                    for (int n = 0; n < 2; ++n) { const size_t o = (size_t)(row0 + ai * 128 + m * 16) * D + col0 + bj * 128 + n * 16; xw[m][bj][n] = *(const u32x2*)(xb + o); pw[m][bj][n] = *(const u32x2*)(pp + o); } }
#pragma unroll
            for (int m = 0; m < 4; ++m) { const int row = row0 + ai * 128 + m * 16; const size_t ro = (size_t)row * D + col0; const float rs = rsv[m] * (1.0f / WSCALE); float ss = 0.f;
#pragma unroll
                for (int bj = 0; bj < 2; ++bj)
#pragma unroll
                    for (int n = 0; n < 2; ++n) { const size_t o = ro + bj * 128 + n * 16; const u32x2 xq = xw[m][bj][n], pq = pw[m][bj][n];
                        const f32x4 a4 = acc[ai][bj][m][n] * rs; f32x4 v;
                        v[0] = bf_lo(xq.x) + sigmoidf_(a4[0]) * bf_lo(pq.x); v[1] = bf_hi(xq.x) + sigmoidf_(a4[1]) * bf_hi(pq.x); v[2] = bf_lo(xq.y) + sigmoidf_(a4[2]) * bf_lo(pq.y); v[3] = bf_hi(xq.y) + sigmoidf_(a4[3]) * bf_hi(pq.y);
                        ss += (v[0] * v[0] + v[1] * v[1]) + (v[2] * v[2] + v[3] * v[3]); *(u32x2*)(xb + o) = (u32x2){pk2(v[0], v[1]), pk2(v[2], v[3])}; }
                ss += __shfl_xor(ss, 16); ss += __shfl_xor(ss, 32);
                if (fq == 0) ssp[(size_t)(u.pn * 4 + wc) * NTOK + row] = ss; }
            asm volatile("" ::: "memory"); }
    }
};
__device__ __forceinline__ float logsigmoid_(float x) { return fminf(x, 0.f) - 0.6931471805599453f * __builtin_amdgcn_logf(1.0f + fast_exp2(-LOG2E * fabsf(x))); }
__device__ __forceinline__ void gla_pre(LAS unsigned char* lds, bf16_t* QG, const bf16_t* KG, const bf16_t* UG, const bf16_t* VGT, const float* __restrict__ b_gk,
                                        bf16_t* KTT, float* DL, bf16_t* OG, int G, int bid, int tid) {
    const int lane = tid & 63, wid = __builtin_amdgcn_readfirstlane(tid >> 6), l15 = lane & 15, lq = lane >> 4;
    constexpr int QS_OFF = 0, KM_OFF = 16640, KP_OFF = 33280, AM_OFF = 51712, SEG_OFF = 60928;
    LAS unsigned char* QS = lds + QS_OFF; LAS unsigned char* KM = lds + KM_OFF; LAS unsigned char* KP = lds + KP_OFF; LAS unsigned char* AM = lds + AM_OFF; LAS float* SEGT = (LAS float*)(lds + SEG_OFF);
    const int dp = lane, seg = wid;
#define GP_BAR() do { asm volatile("s_waitcnt lgkmcnt(0)" ::: "memory"); __builtin_amdgcn_s_barrier(); asm volatile("" ::: "memory"); } while (0)
#define GP_LOAD_QKU(uu) do { const int b_ = (uu) >> 8, c_ = ((uu) >> 2) & 63, hg_ = (uu) & 3; \
        _Pragma("unroll") for (int i = 0; i < 8; ++i) { const size_t off = (size_t)(b_ * TSEQ + c_ * 64 + 8 * seg + i) * 512 + hg_ * 128 + 2 * dp; \
            uwv[i] = *(const unsigned*)(UG + off); qw[i] = *(const unsigned*)(QG + off); kw[i] = *(const unsigned*)(KG + off); } } while (0)
#define GP_LOAD_V(uu) do { const int b_ = (uu) >> 8, c_ = ((uu) >> 2) & 63, hg_ = (uu) & 3; \
        _Pragma("unroll") for (int dvt = 0; dvt < 2; ++dvt) _Pragma("unroll") for (int kk = 0; kk < 2; ++kk) \
            vfr[dvt][kk] = *(const bf16x8*)(VGT + ((size_t)(b_ * NCH + c_) * 2048 + hg_ * 256 + 32 * wid + 16 * dvt + l15) * 64 + 32 * kk + 8 * lq); } while (0)
    unsigned uwv[8], qw[8], kw[8]; bf16x8 vfr[2][2];
    if (bid < NB * NCH * 4) { GP_LOAD_QKU(bid); GP_LOAD_V(bid); }
    for (int u = bid; u < NB * NCH * 4; u += G) {
        const int b = u >> 8, c = (u >> 2) & 63, hg = u & 3;
        const int tok0 = b * TSEQ + c * 64;
        const int un = u + G; const bool hasn = un < NB * NCH * 4;
        const float bias0 = b_gk[hg * 128 + 2 * dp], bias1 = b_gk[hg * 128 + 2 * dp + 1];
        float cum0[8], cum1[8]; float run0 = 0.f, run1 = 0.f;
#pragma unroll
        for (int i = 0; i < 8; ++i) { const unsigned uw = uwv[i];
            run0 += logsigmoid_(bf_lo(uw) + bias0) * 0.0625f; run1 += logsigmoid_(bf_hi(uw) + bias1) * 0.0625f; cum0[i] = run0; cum1[i] = run1; }
        *(LAS f32x2*)(SEGT + seg * 128 + 2 * dp) = (f32x2){run0, run1};
        GP_BAR();
        float off0 = 0.f, off1 = 0.f, tot0 = 0.f, tot1 = 0.f;
#pragma unroll
        for (int s = 0; s < 8; ++s) { const f32x2 v = *(const LAS f32x2*)(SEGT + s * 128 + 2 * dp); if (s < seg) { off0 += v.x; off1 += v.y; } tot0 += v.x; tot1 += v.y; }
        unsigned kpa[4], kpb[4]; float kp0p = 0.f, kp1p = 0.f;
#pragma unroll
        for (int i = 0; i < 8; ++i) { const float b0 = (cum0[i] + off0) * LOG2E, b1 = (cum1[i] + off1) * LOG2E;
            const float e0 = fast_exp2(b0), e1 = fast_exp2(b1), em0 = fast_exp2(-b0), em1 = fast_exp2(-b1), ep0 = fast_exp2(tot0 * LOG2E - b0), ep1 = fast_exp2(tot1 * LOG2E - b1);
            const float q0 = bf_lo(qw[i]), q1 = bf_hi(qw[i]), k0 = bf_lo(kw[i]), k1 = bf_hi(kw[i]);
            const unsigned qt = pk2(q0 * e0, q1 * e1), km = pk2(k0 * em0, k1 * em1);
            const int t = 8 * seg + i; const size_t off = (size_t)(tok0 + t) * 512 + hg * 128 + 2 * dp;
            *(unsigned*)(QG + off) = qt;
            const int la = (dp >> 2) * 1040 + t * 16 + (dp & 3) * 4;
            *(LAS unsigned*)(QS + la) = qt; *(LAS unsigned*)(KM + la) = km;
            const float kp0 = k0 * ep0, kp1 = k1 * ep1;
            if (i & 1) { kpa[i >> 1] = pk2(kp0p, kp0); kpb[i >> 1] = pk2(kp1p, kp1); } else { kp0p = kp0; kp1p = kp1; } }
        *(LAS u32x4*)(KP + (2 * dp) * 144 + 16 * seg) = (u32x4){kpa[0], kpa[1], kpa[2], kpa[3]};
        *(LAS u32x4*)(KP + (2 * dp + 1) * 144 + 16 * seg) = (u32x4){kpb[0], kpb[1], kpb[2], kpb[3]};
        if (seg == 0) *(f32x2*)(DL + (size_t)u * 128 + 2 * dp) = (f32x2){fast_exp2(tot0 * LOG2E), fast_exp2(tot1 * LOG2E)};
        if (hasn) GP_LOAD_QKU(un);
        GP_BAR();
#pragma unroll
        for (int j = 0; j < 2; ++j) { const int ch = tid + 512 * j, dk = ch >> 3, part = ch & 7; *(u32x4*)(KTT + (size_t)u * 8192 + ch * 8) = *(const LAS u32x4*)(KP + dk * 144 + part * 16); }
        { const int st = wid >> 1, ttb = 2 * (wid & 1); f32x4 d1[2] = {(f32x4){0.f, 0.f, 0.f, 0.f}, (f32x4){0.f, 0.f, 0.f, 0.f}};
#pragma unroll
          for (int kk = 0; kk < 4; ++kk) { const int chunk = 4 * kk + lq; const bf16x8 af = *(const LAS bf16x8*)(KM + chunk * 1040 + (16 * st + l15) * 16);
#pragma unroll
              for (int x = 0; x < 2; ++x) { const bf16x8 bfr = *(const LAS bf16x8*)(QS + chunk * 1040 + (16 * (ttb + x) + l15) * 16); d1[x] = MFMA16(af, bfr, d1[x]); } }
#pragma unroll
          for (int x = 0; x < 2; ++x) { const int t = 16 * (ttb + x) + l15, s0 = 16 * st + 4 * lq; float v[4];
#pragma unroll
              for (int i = 0; i < 4; ++i) v[i] = (t >= s0 + i) ? d1[x][i] : 0.f;
              *(LAS u32x2*)(AM + t * 144 + s0 * 2) = (u32x2){pk2(v[0], v[1]), pk2(v[2], v[3])}; } }
        GP_BAR();
        { f32x4 o[2][4];
#pragma unroll
          for (int dvt = 0; dvt < 2; ++dvt)
#pragma unroll
              for (int tt = 0; tt < 4; ++tt) o[dvt][tt] = (f32x4){0.f, 0.f, 0.f, 0.f};
#pragma unroll
          for (int tt = 0; tt < 4; ++tt)
#pragma unroll
              for (int kk = 0; kk < 2; ++kk) { const bf16x8 bfr = *(const LAS bf16x8*)(AM + (16 * tt + l15) * 144 + (32 * kk + 8 * lq) * 2);
#pragma unroll
                  for (int dvt = 0; dvt < 2; ++dvt) o[dvt][tt] = MFMA16(vfr[dvt][kk], bfr, o[dvt][tt]); }
          if (hasn) GP_LOAD_V(un);
#pragma unroll
          for (int dvt = 0; dvt < 2; ++dvt)
#pragma unroll
              for (int tt = 0; tt < 4; ++tt) { const f32x4 v = o[dvt][tt];
                  *(u32x2*)(OG + (size_t)(tok0 + 16 * tt + l15) * D + hg * 256 + 32 * wid + 16 * dvt + 4 * lq) = (u32x2){pk2(v[0], v[1]), pk2(v[2], v[3])}; } }
        GP_BAR();
    }
    asm volatile("s_waitcnt vmcnt(0)" ::: "memory");
#undef GP_BAR
#undef GP_LOAD_QKU
#undef GP_LOAD_V
}

__device__ __forceinline__ void gla_scan(LAS unsigned char* lds, const bf16_t* QT, const bf16_t* KTT, const bf16_t* VGT, const float* DL, bf16_t* OG, float* OGSS, int G, int bid, int tid, int variant) {
    const int lane = tid & 63, wid = __builtin_amdgcn_readfirstlane(tid >> 6), l15 = lane & 15, lq = lane >> 4;
    const int dvt = wid & 1, tt = wid >> 1;
    constexpr int STG = 40960, ST_OFF = 122880, STB = 32 * 272;
    int qoff[4], koff[2], voff[2][2];
#pragma unroll
    for (int kk = 0; kk < 4; ++kk) qoff[kk] = (16 * tt + l15) * 256 + (((4 * kk + lq) ^ l15) << 4);
#pragma unroll
    for (int kk = 0; kk < 2; ++kk) { const int dk = 16 * wid + l15; koff[kk] = 16384 + dk * 128 + (((4 * kk + lq) ^ ((dk >> 1) & 7)) << 4);
#pragma unroll
        for (int nt = 0; nt < 2; ++nt) { const int dv = 16 * nt + l15; voff[nt][kk] = 32768 + dv * 128 + (((4 * kk + lq) ^ ((dv >> 1) & 7)) << 4); } }
    const int ooff = 36864 + (16 * tt + l15) * 64 + 32 * dvt + 8 * lq;
    for (int u = bid; u < NB * 4 * 8; u += G) {
        const int b = u >> 5, hg = (u >> 3) & 3, sl = u & 7;
        f32x4 S[2] = {(f32x4){0.f, 0.f, 0.f, 0.f}, (f32x4){0.f, 0.f, 0.f, 0.f}};
        for (int i = tid; i < STB / 16; i += 512) *(LAS u32x4*)(lds + ST_OFF + i * 16) = (u32x4){0u, 0u, 0u, 0u};
        bf16_t* op = OG + (size_t)(b * TSEQ + 16 * tt + l15) * D + hg * 256 + sl * 32 + 16 * dvt + 4 * lq;
        const float* dp = DL + (size_t)(b * 256 + hg) * 128 + 16 * wid + 4 * lq;
        float* ssp = OGSS + ((size_t)(b * TSEQ + 16 * tt + l15) * 4 + hg) * 16 + sl * 2 + dvt;
        const bf16_t* gq[2]; const bf16_t* gk[2]; const bf16_t* gv;
#pragma unroll
        for (int x = 0; x < 2; ++x) { const int j = 2 * wid + x;
            { const int row = 4 * j + (lane >> 4), ch = (lane & 15) ^ (row & 15); gq[x] = QT + (size_t)(b * TSEQ + row) * 512 + hg * 128 + 8 * ch; }
            { const int row = 8 * j + (lane >> 3), ch = (lane & 7) ^ ((row >> 1) & 7); gk[x] = KTT + (size_t)(b * 256 + hg) * 8192 + row * 64 + 8 * ch; } }
        if (wid < 4) { const int row = 8 * wid + (lane >> 3), ch = (lane & 7) ^ ((row >> 1) & 7); gv = VGT + ((size_t)(b * NCH) * 2048 + hg * 256 + sl * 32 + row) * 64 + 8 * ch; }
        else { const int row = 16 * (wid - 4) + (lane >> 2); gv = OG + (size_t)(b * TSEQ + row) * D + hg * 256 + sl * 32 + 8 * (lane & 3); }
        const size_t gvstep = wid < 4 ? (size_t)2048 * 64 : (size_t)64 * D;
#define SCAN_DMA(c, sidx) do { if (!(variant & 2)) { LAS unsigned char* sb_ = lds + (sidx) * STG; \
        _Pragma("unroll") for (int x = 0; x < 2; ++x) { \
            __builtin_amdgcn_global_load_lds((const unsigned*)(gq[x] + (size_t)(c) * 64 * 512), (LAS unsigned*)(sb_ + (2 * wid + x) * 1024), 16, 0, 0); \
            __builtin_amdgcn_global_load_lds((const unsigned*)(gk[x] + (size_t)(c) * 4 * 8192), (LAS unsigned*)(sb_ + 16384 + (2 * wid + x) * 1024), 16, 0, 0); } \
        __builtin_amdgcn_global_load_lds((const unsigned*)(gv + (size_t)(c) * gvstep), (LAS unsigned*)(sb_ + 32768 + wid * 1024), 16, 0, 0); } } while (0)
#define SCAN_STEP(c, sidx, DV, WAITN) do { const LAS unsigned char* sb = lds + (sidx) * STG; \
        const LAS unsigned char* stc = lds + ST_OFF + ((c) & 1) * STB; LAS unsigned char* stn = lds + ST_OFF + (((c) & 1) ^ 1) * STB; \
        f32x4 oT = (f32x4){0.f, 0.f, 0.f, 0.f}; \
        _Pragma("unroll") for (int kk = 0; kk < 4; ++kk) { const bf16x8 sa = *(const LAS bf16x8*)(stc + (16 * dvt + l15) * 272 + (32 * kk + 8 * lq) * 2); const bf16x8 qb = *(const LAS bf16x8*)(sb + qoff[kk]); oT = MFMA16(sa, qb, oT); } \
        f32x4 dS0 = (f32x4){0.f, 0.f, 0.f, 0.f}, dS1 = (f32x4){0.f, 0.f, 0.f, 0.f}; \
        _Pragma("unroll") for (int kk = 0; kk < 2; ++kk) { const bf16x8 ka = *(const LAS bf16x8*)(sb + koff[kk]); dS0 = MFMA16(ka, *(const LAS bf16x8*)(sb + voff[0][kk]), dS0); dS1 = MFMA16(ka, *(const LAS bf16x8*)(sb + voff[1][kk]), dS1); } \
        const u32x2 oi = *(const LAS u32x2*)(sb + ooff); \
        S[0] = S[0] * DV + dS0; S[1] = S[1] * DV + dS1; \
        *(LAS u32x2*)(stn + (l15) * 272 + (16 * wid + 4 * lq) * 2) = (u32x2){pk2(S[0][0], S[0][1]), pk2(S[0][2], S[0][3])}; \
        *(LAS u32x2*)(stn + (16 + l15) * 272 + (16 * wid + 4 * lq) * 2) = (u32x2){pk2(S[1][0], S[1][1]), pk2(S[1][2], S[1][3])}; \
        const float o0 = oT[0] + bf_lo(oi.x), o1 = oT[1] + bf_hi(oi.x), o2 = oT[2] + bf_lo(oi.y), o3 = oT[3] + bf_hi(oi.y); \
        if (!(variant & 4)) *(u32x2*)(op + (size_t)(c) * 64 * D) = (u32x2){pk2(o0, o1), pk2(o2, o3)}; \
        float ss = (o0 * o0 + o1 * o1) + (o2 * o2 + o3 * o3); ss += __shfl_xor(ss, 16); ss += __shfl_xor(ss, 32); \
        if (lane < 16 && !(variant & 4)) ssp[(size_t)(c) * 64 * 64] = ss; \
        asm volatile("s_waitcnt vmcnt(" #WAITN ") lgkmcnt(0)" ::: "memory"); __builtin_amdgcn_s_barrier(); asm volatile("" ::: "memory"); } while (0)
        f32x4 dA, dB, dC;
        SCAN_DMA(0, 0); dA = *(const f32x4*)(dp); SCAN_DMA(1, 1); dB = *(const f32x4*)(dp + 4 * 128);
        asm volatile("s_waitcnt vmcnt(0) lgkmcnt(0)" ::: "memory"); __builtin_amdgcn_s_barrier(); asm volatile("" ::: "memory");
        for (int c = 0; c < 60; c += 3) {
            SCAN_DMA(c + 2, 2); dC = *(const f32x4*)(dp + (size_t)(c + 2) * 4 * 128); SCAN_STEP(c, 0, dA, 8);
            SCAN_DMA(c + 3, 0); dA = *(const f32x4*)(dp + (size_t)(c + 3) * 4 * 128); SCAN_STEP(c + 1, 1, dB, 8);
            SCAN_DMA(c + 4, 1); dB = *(const f32x4*)(dp + (size_t)(c + 4) * 4 * 128); SCAN_STEP(c + 2, 2, dC, 8);
        }
        SCAN_DMA(62, 2); dC = *(const f32x4*)(dp + (size_t)62 * 4 * 128); SCAN_STEP(60, 0, dA, 0);
        SCAN_DMA(63, 0); dA = *(const f32x4*)(dp + (size_t)63 * 4 * 128); SCAN_STEP(61, 1, dB, 0);
        SCAN_STEP(62, 2, dC, 0);
        SCAN_STEP(63, 0, dA, 0);
#undef SCAN_DMA
#undef SCAN_STEP
        asm volatile("s_waitcnt vmcnt(0)" ::: "memory"); __syncthreads();
    }
}

__device__ __forceinline__ void attn_softmax_blk(f32x16& p0, f32x16& p1, f32x16& O0, f32x16& O1, float& mrun, float& lsum, bf16x8 (&pf)[4]) {
    const float PINF = __builtin_inff();
    float m0 = __builtin_amdgcn_fmed3f(p0[0], p1[0], PINF), m1 = __builtin_amdgcn_fmed3f(p0[1], p1[1], PINF), m2 = __builtin_amdgcn_fmed3f(p0[2], p1[2], PINF), m3 = __builtin_amdgcn_fmed3f(p0[3], p1[3], PINF);
#pragma unroll
    for (int r = 4; r < 16; r += 4) {
        m0 = __builtin_amdgcn_fmed3f(m0, p0[r], PINF); m1 = __builtin_amdgcn_fmed3f(m1, p0[r + 1], PINF); m2 = __builtin_amdgcn_fmed3f(m2, p0[r + 2], PINF); m3 = __builtin_amdgcn_fmed3f(m3, p0[r + 3], PINF);
        m0 = __builtin_amdgcn_fmed3f(m0, p1[r], PINF); m1 = __builtin_amdgcn_fmed3f(m1, p1[r + 1], PINF); m2 = __builtin_amdgcn_fmed3f(m2, p1[r + 2], PINF); m3 = __builtin_amdgcn_fmed3f(m3, p1[r + 3], PINF); }
    float mx = __builtin_amdgcn_fmed3f(__builtin_amdgcn_fmed3f(m0, m1, PINF), __builtin_amdgcn_fmed3f(m2, m3, PINF), PINF);
    mx = __builtin_amdgcn_fmed3f(mx, __shfl_xor(mx, 32), PINF);
    const float mnew = __builtin_amdgcn_fmed3f(mrun, mx, PINF);
    { const float alpha = fast_exp2(mrun - mnew); lsum *= alpha;
#pragma unroll
        for (int r = 0; r < 16; ++r) { O0[r] *= alpha; O1[r] *= alpha; } }
    mrun = mnew;
    const f32x2 mm = (f32x2){mnew, mnew}; f32x2 ps2 = (f32x2){0.f, 0.f};
#pragma unroll
    for (int r = 0; r < 16; r += 2) {
        f32x2 a = (f32x2){p0[r], p0[r + 1]} - mm, b = (f32x2){p1[r], p1[r + 1]} - mm;
        a.x = fast_exp2(a.x); a.y = fast_exp2(a.y); b.x = fast_exp2(b.x); b.y = fast_exp2(b.y);
        p0[r] = a.x; p0[r + 1] = a.y; p1[r] = b.x; p1[r + 1] = b.y; ps2 += a; ps2 += b; }
    lsum += ps2.x + ps2.y;
    u32x4 w;
    w = (u32x4){pk2(p0[0], p0[1]), pk2(p0[2], p0[3]), pk2(p0[4], p0[5]), pk2(p0[6], p0[7])}; pf[0] = __builtin_bit_cast(bf16x8, w);
    w = (u32x4){pk2(p0[8], p0[9]), pk2(p0[10], p0[11]), pk2(p0[12], p0[13]), pk2(p0[14], p0[15])}; pf[1] = __builtin_bit_cast(bf16x8, w);
    w = (u32x4){pk2(p1[0], p1[1]), pk2(p1[2], p1[3]), pk2(p1[4], p1[5]), pk2(p1[6], p1[7])}; pf[2] = __builtin_bit_cast(bf16x8, w);
    w = (u32x4){pk2(p1[8], p1[9]), pk2(p1[10], p1[11]), pk2(p1[12], p1[13]), pk2(p1[14], p1[15])}; pf[3] = __builtin_bit_cast(bf16x8, w);
}
__device__ __forceinline__ void attn_bias_init(f32x16& p0, f32x16& p1, const LAS float* bt, bool table, float bconst) {
    if (table) {
#pragma unroll
        for (int g = 0; g < 4; ++g) { const f32x4 a = *(const LAS f32x4*)(bt + 8 * g), bq = *(const LAS f32x4*)(bt + 8 * g + 32);
#pragma unroll
            for (int i = 0; i < 4; ++i) { p0[4 * g + i] = a[i]; p1[4 * g + i] = bq[i]; } } }
    else {
#pragma unroll
        for (int r = 0; r < 16; ++r) { p0[r] = bconst; p1[r] = bconst; } }
}
__device__ __forceinline__ void attn_stage_yb(LAS unsigned char* yt, const f32x16& O0, const f32x16& O1, float inv, int row, int hi) {
#pragma unroll
    for (int d0 = 0; d0 < 2; ++d0)
#pragma unroll
        for (int g = 0; g < 4; ++g) { const int col = 32 * d0 + 8 * g + 4 * hi; float v[4];
#pragma unroll
            for (int i = 0; i < 4; ++i) v[i] = (d0 ? O1[4 * g + i] : O0[4 * g + i]) * inv;
            *(LAS u32x2*)(yt + row * 144 + col * 2) = (u32x2){pk2(v[0], v[1]), pk2(v[2], v[3])}; }
}
__device__ __forceinline__ void attn_merge_rows(const LAS unsigned char* yt, const LAS float* rsr, size_t tok0, int h, int lane, const bf16_t* OG, const bf16_t* RG, const bf16_t* GA, const bf16_t* GBt,
                                                const float* __restrict__ gla_norm, bf16_t* H) {
    const int c8 = lane & 7, col = h * 64 + 8 * c8;
    const f32x4 gn0 = *(const f32x4*)(gla_norm + (col & 255)), gn1 = *(const f32x4*)(gla_norm + (col & 255) + 4);
    u32x4 ogv[8], rgv[8], gav[8], gbv[8];
#pragma unroll
    for (int i = 0; i < 8; ++i) { const size_t o = (tok0 + 8 * i + (lane >> 3)) * D + col;
        ogv[i] = *(const u32x4*)(OG + o); rgv[i] = *(const u32x4*)(RG + o); gav[i] = *(const u32x4*)(GA + o); gbv[i] = *(const u32x4*)(GBt + o); }
#pragma unroll
    for (int i = 0; i < 8; ++i) { const int row = 8 * i + (lane >> 3); const size_t o = (tok0 + row) * D + col;
        const u32x4 og = ogv[i], rg = rgv[i], ga = gav[i], gb = gbv[i];
        const u32x4 yb = *(const LAS u32x4*)(yt + row * 144 + c8 * 16); const float rstdg = rsr[row];
        unsigned w[4];
#pragma unroll
        for (int q = 0; q < 4; ++q) { const float g0 = q < 2 ? gn0[2 * q] : gn1[2 * q - 4], g1 = q < 2 ? gn0[2 * q + 1] : gn1[2 * q - 3];
            float hv[2];
#pragma unroll
            for (int e = 0; e < 2; ++e) { const float r = e ? bf_hi(rg[q]) : bf_lo(rg[q]), a = e ? bf_hi(ga[q]) : bf_lo(ga[q]), bb = e ? bf_hi(gb[q]) : bf_lo(gb[q]);
                const float ogx = e ? bf_hi(og[q]) : bf_lo(og[q]), ybx = e ? bf_hi(yb[q]) : bf_lo(yb[q]), gnx = e ? g1 : g0;
                const float ea = 1.0f + fast_exp2(__builtin_amdgcn_fmed3f(-LOG2E * a, -40.f, 40.f)), er = 1.0f + fast_exp2(__builtin_amdgcn_fmed3f(-LOG2E * r, -40.f, 40.f)), eb = 1.0f + fast_exp2(__builtin_amdgcn_fmed3f(-LOG2E * bb, -40.f, 40.f));
                const float ear = ea * er, n1 = ogx * rstdg * gnx * r;
                hv[e] = (n1 * eb + ybx * ear) * fast_rcp(ear * eb); }
            w[q] = pk2(hv[0], hv[1]); }
        *(u32x4*)(H + o) = (u32x4){w[0], w[1], w[2], w[3]}; }
}
__device__ __forceinline__ void attn_phase(LAS unsigned char* lds, const bf16_t* QA, const bf16_t* KA, const bf16_t* VAT, const bf16_t* OG, const bf16_t* RG, const bf16_t* GA, const bf16_t* GBt,
                                           const float* OGSS, const float* __restrict__ gla_norm, const float* __restrict__ rel_bias, bf16_t* H, int G, int vcu, int tid, int variant) {
    const int lane = tid & 63, wid = __builtin_amdgcn_readfirstlane(tid >> 6), r32 = lane & 31, hi = lane >> 5;
    const int hh = wid >> 1, cq = wid & 1;
    LAS float* RTC = (LAS float*)(lds + ATT_BT_OFF);
    const int sw = (r32 >> 1) & 7;
    int rtc_hgp = -1;
    const int kvbase = hh * 8192 + r32 * 128;
    const int bsA = (63 - r32) & 3, bsB = (31 - r32) & 3;
    const int ybA = (hh * 4 + bsA) * 384 + (63 - r32 - bsA) + 4 * hi - 256;
    const int ybB = (hh * 4 + bsB) * 384 + (31 - r32 - bsB) + 4 * hi - 256;
    for (int u = vcu; u < NB * (NCH / 2) * 4; u += G) {
        const int b = u >> 7, c0 = 2 * ((u >> 2) & 31), hgp = u & 3, h = 4 * hgp + hh;
        const int tqA = b * TSEQ + (c0 + cq) * 64 + r32;
        if (hgp != rtc_hgp) {
            float tv[12];
#pragma unroll
            for (int q = 0; q < 12; ++q) { const int i = tid + 512 * q; const int hq = i / 1536, rem = i - hq * 1536, s = rem / 384, y = rem - s * 384; int d = 319 - (y + s); d = d > 256 ? 256 : d; tv[q] = rel_bias[(4 * hgp + hq) * 513 + d + 256]; }
#pragma unroll
            for (int q = 0; q < 12; ++q) RTC[tid + 512 * q] = LOG2E * tv[q];
            rtc_hgp = hgp; }
        const float bconst = LOG2E * rel_bias[h * 513 + 512];
        bf16x8 qfA[4], qfB[4];
#pragma unroll
        for (int d0 = 0; d0 < 4; ++d0) { qfA[d0] = *(const bf16x8*)(QA + (size_t)tqA * D + h * 64 + 16 * d0 + 8 * hi); qfB[d0] = *(const bf16x8*)(QA + (size_t)(tqA + 32) * D + h * 64 + 16 * d0 + 8 * hi); }
        const int smin = c0 >= 8 ? 0 : 8 - c0;
#define ATT_DMA(st, buf) do { const int tokk = b * TSEQ + (c0 - 8 + (st)) * 64; int ls_ = lane; asm volatile("" : "+v"(ls_));     \
        const char* kb_ = (const char*)(KA + (size_t)tokk * D + h * 64); const char* vb_ = (const char*)(VAT + ((size_t)(tokk >> 6) * 2048 + 1024 + h * 64) * 64); \
        _Pragma("unroll") for (int i = 0; i < 4; ++i) { const int row = 8 * (4 * cq + i) + (ls_ >> 3); const int gch = (ls_ & 7) ^ ((row >> 1) & 7); \
            __builtin_amdgcn_global_load_lds((const unsigned*)(kb_ + (unsigned)(row * (D * 2) + gch * 16)), (LAS unsigned*)(lds + (buf) * 65536 + hh * 8192 + (4 * cq + i) * 1024), 16, 0, 0); \
            __builtin_amdgcn_global_load_lds((const unsigned*)(vb_ + (unsigned)(row * 128 + gch * 16)), (LAS unsigned*)(lds + (buf) * 65536 + 32768 + hh * 8192 + (4 * cq + i) * 1024), 16, 0, 0); } } while (0)
        ATT_DMA(smin, smin & 1);
        f32x16 OA0, OA1, OB0, OB1;
#pragma unroll
        for (int r = 0; r < 16; ++r) { OA0[r] = 0.f; OA1[r] = 0.f; OB0[r] = 0.f; OB1[r] = 0.f; }
        float mA = -INFINITY, lA = 0.f, mB = -INFINITY, lB = 0.f;
        asm volatile("s_waitcnt vmcnt(0)" ::: "memory");
        __syncthreads();
        for (int st = smin; st <= 9; ++st) {
            const int buf = st & 1;
            if (st < 9 && !(variant & 2)) ATT_DMA(st + 1, buf ^ 1);
            const int j = st - cq;
            if (j >= 0 && j <= 8 && !(variant & 1)) {
                const LAS unsigned char* tb = lds + buf * 65536 + kvbase;
                int swl = sw; asm volatile("" : "+v"(swl));
#define KADDR(d0) ((((2 * (d0) + hi) ^ swl) << 4))
#define VADDR(cc) (32768 + ((((cc) ^ swl) << 4)) + 8 * hi)
                f32x16 pA0, pA1, pB0, pB1;
                attn_bias_init(pA0, pA1, RTC + ybA + 64 * j, j >= 4, bconst);
                attn_bias_init(pB0, pB1, RTC + ybB + 64 * j, j >= 4, bconst);
#pragma unroll
                for (int d0 = 0; d0 < 4; ++d0) { const bf16x8 k0 = *(const LAS bf16x8*)(tb + KADDR(d0)), k1 = *(const LAS bf16x8*)(tb + KADDR(d0) + 4096);
                    pA0 = MFMA32(k0, qfA[d0], pA0); pA1 = MFMA32(k1, qfA[d0], pA1); }
                __builtin_amdgcn_sched_barrier(0);
                bf16x8 pfA[4], pfB[4];
#pragma unroll
                for (int d0 = 0; d0 < 4; ++d0) { const bf16x8 k0 = *(const LAS bf16x8*)(tb + KADDR(d0)), k1 = *(const LAS bf16x8*)(tb + KADDR(d0) + 4096);
                    pB0 = MFMA32(k0, qfB[d0], pB0); pB1 = MFMA32(k1, qfB[d0], pB1); }
                attn_softmax_blk(pA0, pA1, OA0, OA1, mA, lA, pfA);
#pragma unroll
                for (int q = 0; q < 8; ++q) { __builtin_amdgcn_sched_group_barrier(0x8, 1, 0); __builtin_amdgcn_sched_group_barrier(0x2, 14, 0); __builtin_amdgcn_sched_group_barrier(0x400, 4, 0); }
                __builtin_amdgcn_sched_barrier(0);
#pragma unroll
                for (int s = 0; s < 4; ++s) {
                    const s16x4 a0l = *(const LAS s16x4*)(tb + VADDR(2 * s)), a0h = *(const LAS s16x4*)(tb + VADDR(2 * s + 1));
                    const s16x4 a1l = *(const LAS s16x4*)(tb + VADDR(2 * s) + 4096), a1h = *(const LAS s16x4*)(tb + VADDR(2 * s + 1) + 4096);
                    const bf16x8 a0 = __builtin_shufflevector(a0l, a0h, 0, 1, 2, 3, 4, 5, 6, 7), a1 = __builtin_shufflevector(a1l, a1h, 0, 1, 2, 3, 4, 5, 6, 7);
                    OA0 = MFMA32(a0, pfA[s], OA0); OA1 = MFMA32(a1, pfA[s], OA1); }
                attn_softmax_blk(pB0, pB1, OB0, OB1, mB, lB, pfB);
#pragma unroll
                for (int q = 0; q < 8; ++q) { __builtin_amdgcn_sched_group_barrier(0x8, 1, 0); __builtin_amdgcn_sched_group_barrier(0x2, 14, 0); __builtin_amdgcn_sched_group_barrier(0x400, 4, 0); }
                __builtin_amdgcn_sched_barrier(0);
#pragma unroll
                for (int s = 0; s < 4; ++s) {
                    const s16x4 a0l = *(const LAS s16x4*)(tb + VADDR(2 * s)), a0h = *(const LAS s16x4*)(tb + VADDR(2 * s + 1));
                    const s16x4 a1l = *(const LAS s16x4*)(tb + VADDR(2 * s) + 4096), a1h = *(const LAS s16x4*)(tb + VADDR(2 * s + 1) + 4096);
                    const bf16x8 a0 = __builtin_shufflevector(a0l, a0h, 0, 1, 2, 3, 4, 5, 6, 7), a1 = __builtin_shufflevector(a1l, a1h, 0, 1, 2, 3, 4, 5, 6, 7);
                    OB0 = MFMA32(a0, pfB[s], OB0); OB1 = MFMA32(a1, pfB[s], OB1); }
            }
            asm volatile("s_waitcnt vmcnt(0)" ::: "memory");
            __syncthreads();
        }
#undef ATT_DMA
#undef KADDR
#undef VADDR
        lA += __shfl_xor(lA, 32); lB += __shfl_xor(lB, 32);
        if (!(variant & 4)) {
            int le = lane; asm volatile("" : "+v"(le));
            const int r32e = le & 31, hie = le >> 5;
            LAS unsigned char* yt = lds + wid * 16384; LAS float* rsr = (LAS float*)(yt + 9216);
            const size_t tok0 = (size_t)b * TSEQ + (c0 + cq) * 64;
            { float ss = 0.f; const f32x4* sp = (const f32x4*)(OGSS + ((tok0 + le) * 4 + hgp) * 16);
#pragma unroll
              for (int k = 0; k < 4; ++k) { const f32x4 v = sp[k]; ss += (v.x + v.y) + (v.z + v.w); }
              rsr[le] = 1.0f / sqrtf(ss * (1.0f / 256.0f) + EPS); }
            attn_stage_yb(yt, OA0, OA1, 1.0f / lA, r32e, hie);
            attn_stage_yb(yt, OB0, OB1, 1.0f / lB, 32 + r32e, hie);
            asm volatile("s_waitcnt lgkmcnt(0)" ::: "memory");
            attn_merge_rows(yt, rsr, tok0, h, le, OG, RG, GA, GBt, gla_norm, H);
        }
        asm volatile("s_waitcnt lgkmcnt(0)" ::: "memory"); __builtin_amdgcn_s_barrier(); asm volatile("" ::: "memory");
    }
}
__device__ __forceinline__ void router_phase(LAS unsigned char* lds, const float* x1, const bf16_t* WRH, const bf16_t* WRL, const float* __restrict__ b_router,
                                             int* TOPI, float* TOPW, float* RSTD1, int* CNT, int G, int bid, int tid) {
    const int lane = tid & 63, wid = __builtin_amdgcn_readfirstlane(tid >> 6), l15 = lane & 15, lq = lane >> 4;
    LAS float* LG = (LAS float*)lds;
    LAS float* RS = (LAS float*)(lds + 128 * 33 * 4);
    LAS int* HIST = (LAS int*)(lds + 128 * 33 * 4 + 512);
    constexpr int WPITCH = 2064; LAS unsigned char* WH = lds + 18432; LAS unsigned char* WL = WH + 32 * WPITCH;
    for (int i = tid; i < 32 * 128; i += 512) { const int e = i >> 7, ch = i & 127;
        *(LAS u32x4*)(WH + e * WPITCH + ch * 16) = *(const u32x4*)(WRH + (size_t)e * D + ch * 8); *(LAS u32x4*)(WL + e * WPITCH + ch * 16) = *(const u32x4*)(WRL + (size_t)e * D + ch * 8); }
    __syncthreads();
    for (int tix = bid; tix < NTOK / 128; tix += G) {
        if (tid < 32) HIST[tid] = 0;
        const int tok = tix * 128 + 16 * wid + l15;
        const float* xr = x1 + (size_t)tok * D + 8 * lq;
        f32x4 acc0 = (f32x4){0.f, 0.f, 0.f, 0.f}, acc1 = (f32x4){0.f, 0.f, 0.f, 0.f}; float ss = 0.f;
#pragma unroll 1
        for (int kb = 0; kb < 32; kb += 8) {
            f32x4 xa[8], xb[8];
#pragma unroll
            for (int q = 0; q < 8; ++q) { xa[q] = *(const f32x4*)(xr + 32 * (kb + q)); xb[q] = *(const f32x4*)(xr + 32 * (kb + q) + 4); }
#pragma unroll
            for (int q = 0; q < 8; ++q) { const int ks = kb + q; const f32x4 a = xa[q], b = xb[q];
                ss += (a.x * a.x + a.y * a.y) + (a.z * a.z + a.w * a.w) + (b.x * b.x + b.y * b.y) + (b.z * b.z + b.w * b.w);
                const unsigned h0 = pk2(a.x, a.y), h1 = pk2(a.z, a.w), h2 = pk2(b.x, b.y), h3 = pk2(b.z, b.w);
                const unsigned l0 = pk2(a.x - bf_lo(h0), a.y - bf_hi(h0)), l1 = pk2(a.z - bf_lo(h1), a.w - bf_hi(h1)), l2 = pk2(b.x - bf_lo(h2), b.y - bf_hi(h2)), l3 = pk2(b.z - bf_lo(h3), b.w - bf_hi(h3));
                const bf16x8 ahi = __builtin_bit_cast(bf16x8, ((u32x4){h0, h1, h2, h3})), alo = __builtin_bit_cast(bf16x8, ((u32x4){l0, l1, l2, l3}));
                const int wo = (32 * ks + 8 * lq) * 2;
                const bf16x8 bh0 = *(const LAS bf16x8*)(WH + l15 * WPITCH + wo), bh1 = *(const LAS bf16x8*)(WH + (16 + l15) * WPITCH + wo);
                const bf16x8 bl0 = *(const LAS bf16x8*)(WL + l15 * WPITCH + wo), bl1 = *(const LAS bf16x8*)(WL + (16 + l15) * WPITCH + wo);
                acc0 = MFMA16(ahi, bh0, acc0); acc0 = MFMA16(alo, bh0, acc0); acc0 = MFMA16(ahi, bl0, acc0);
                acc1 = MFMA16(ahi, bh1, acc1); acc1 = MFMA16(alo, bh1, acc1); acc1 = MFMA16(ahi, bl1, acc1); }
        }
        ss += __shfl_xor(ss, 16); ss += __shfl_xor(ss, 32);
        const float rstd = 1.0f / sqrtf(ss * (1.f / D) + EPS);
        if (lq == 0) { RS[16 * wid + l15] = rstd; RSTD1[tok] = rstd; }
        __syncthreads();
#pragma unroll
        for (int i = 0; i < 4; ++i) { const int tl = 16 * wid + 4 * lq + i; const float r = RS[tl];
            LG[tl * 33 + l15] = acc0[i] * r + b_router[l15]; LG[tl * 33 + 16 + l15] = acc1[i] * r + b_router[16 + l15]; }
        __syncthreads();
        if (tid < 128) {
            const LAS float* lg = LG + tid * 33; float v[4]; int id[4];
#pragma unroll
            for (int k = 0; k < 4; ++k) { float bv = -INFINITY; int bi = 0;
                for (int e = 0; e < NEXP; ++e) { const float x = lg[e]; bool taken = false;
#pragma unroll
                    for (int q = 0; q < 4; ++q) if (q < k && id[q] == e) taken = true;
                    if (!taken && x > bv) { bv = x; bi = e; } }
                v[k] = bv; id[k] = bi; }
            const float e1 = __expf(v[1] - v[0]), e2 = __expf(v[2] - v[0]), e3 = __expf(v[3] - v[0]); const float inv = 1.0f / (1.0f + e1 + e2 + e3);
            const int t = tix * 128 + tid;
            *(int4*)(TOPI + (size_t)t * 4) = make_int4(id[0], id[1], id[2], id[3]);
            *(f32x4*)(TOPW + (size_t)t * 4) = (f32x4){inv, e1 * inv, e2 * inv, e3 * inv};
#pragma unroll
            for (int k = 0; k < 4; ++k) __hip_atomic_fetch_add(&HIST[id[k]], 1, __ATOMIC_RELAXED, __HIP_MEMORY_SCOPE_WORKGROUP);
        }
        __syncthreads();
        if (tid < 32) CNT[tix * 32 + tid] = HIST[tid];
        __syncthreads();
    }
}

__device__ __forceinline__ void assign_phase(LAS unsigned char* lds, const int* TOPI, const float* TOPW, const float* RSTD1, const int* CNT,
                                             int* TOKSLOT, float* GATESLOT, float* RSTDSLOT, int* SLOTTOK, int* TILEEXP, int* NTILES, int G, int bid, int tid) {
    LAS int* PART = (LAS int*)lds;
    LAS int* PARTB = PART + 512;
    LAS int* TOT = PART + 1024;
    LAS int* BEF = PART + 1056;
    LAS int* BASE = PART + 1088;
    LAS int* IDS = PART + 1120;
    LAS int* WC = PART + 1632;
    constexpr int NTILE = NTOK / 128;
    for (int tix = bid; tix < NTILE; tix += G) {
        { const int e = tid & 31, part = tid >> 5; int s = 0, sb = 0;
          int cv[16];
#pragma unroll
          for (int q = 0; q < 16; ++q) cv[q] = CNT[(part * 16 + q) * 32 + e];
#pragma unroll
          for (int q = 0; q < 16; ++q) { s += cv[q]; if (part * 16 + q < tix) sb += cv[q]; }
          PART[part * 32 + e] = s; PARTB[part * 32 + e] = sb; }
        IDS[tid] = TOPI[(size_t)tix * 512 + tid];
        __syncthreads();
        if (tid < 32) { int s = 0, sb = 0;
            for (int p = 0; p < 16; ++p) { s += PART[p * 32 + tid]; sb += PARTB[p * 32 + tid]; }
            TOT[tid] = s; BEF[tid] = sb; }
        __syncthreads();
        if (tid < 32) { int base = 0; for (int e = 0; e < tid; ++e) base += (TOT[e] + 255) & ~255; BASE[tid] = base; }
        __syncthreads();
        {
            const int lane = tid & 63, w = tid >> 6; const int id = IDS[tid]; int rank = 0, cnt = 0;
            for (int e = 0; e < NEXP; ++e) { const unsigned long long mask = __ballot(id == e); if (lane == e) cnt = __popcll(mask); if (id == e) rank = __popcll(mask & ((1ull << lane) - 1ull)); }
            if (lane < 32) WC[w * 32 + lane] = cnt;
            __syncthreads();
            int pre = 0;
            for (int q = 0; q < 8; ++q) if (q < w) pre += WC[q * 32 + id];
            const int slot = BASE[id] + BEF[id] + pre + rank; const int t = tix * 128 + (tid >> 2);
            TOKSLOT[slot] = t; GATESLOT[slot] = TOPW[(size_t)tix * 512 + tid]; RSTDSLOT[slot] = RSTD1[t]; SLOTTOK[(size_t)tix * 512 + tid] = slot;
        }
        if (tix == 0) {
            if (tid < 32) { const int e = tid, nt = (TOT[e] + 255) >> 8, tb = BASE[e] >> 8;
                for (int i = 0; i < nt; ++i) TILEEXP[tb + i] = e;
                if (e == 31) NTILES[0] = tb + nt; }
            for (int e = 0; e < NEXP; ++e) { const int s0 = BASE[e] + TOT[e], s1 = BASE[e] + ((TOT[e] + 255) & ~255);
                for (int s = s0 + tid; s < s1; s += 512) { TOKSLOT[s] = 0; GATESLOT[s] = 0.f; RSTDSLOT[s] = 0.f; } }
        }
        __syncthreads();
    }
}

__device__ __forceinline__ void combine_row_load(const float* x1, const unsigned char* YS, const int* SLOTTOK, int m, int lane, f32x4 (&v)[4], unsigned (&yw)[4][4]) {
    const int4 sl = *(const int4*)(SLOTTOK + (size_t)m * 4);
    const f32x4* xr = (const f32x4*)(x1 + (size_t)m * D) + lane;
    const int sls[4] = {sl.x, sl.y, sl.z, sl.w};
#pragma unroll
    for (int j = 0; j < 4; ++j) v[j] = xr[64 * j];
#pragma unroll
    for (int k = 0; k < 4; ++k) { const unsigned* yr = (const unsigned*)(YS + (size_t)sls[k] * D) + lane;
#pragma unroll
        for (int j = 0; j < 4; ++j) yw[k][j] = yr[64 * j]; }
}
__device__ __forceinline__ void combine_row_finish(f32x4 (&v)[4], const unsigned (&yw)[4][4], bf16_t* X2B, unsigned char* XF8, float* RSTD2, int m, int lane) {
#pragma unroll
    for (int k = 0; k < 4; ++k)
#pragma unroll
        for (int j = 0; j < 4; ++j) { const unsigned w = yw[k][j]; f32x2 lo = __builtin_amdgcn_cvt_pk_f32_fp8((int)w, false), hi = __builtin_amdgcn_cvt_pk_f32_fp8((int)w, true);
            v[j].x += lo.x * (1.0f / YSCALE); v[j].y += lo.y * (1.0f / YSCALE); v[j].z += hi.x * (1.0f / YSCALE); v[j].w += hi.y * (1.0f / YSCALE); }
    float s = 0.f;
#pragma unroll
    for (int j = 0; j < 4; ++j) s += (v[j].x * v[j].x + v[j].y * v[j].y) + (v[j].z * v[j].z + v[j].w * v[j].w);
    s = wave_sum(s);
    u32x2* ob = (u32x2*)(X2B + (size_t)m * D) + lane; unsigned* o8 = (unsigned*)(XF8 + (size_t)m * D) + lane;
#pragma unroll
    for (int j = 0; j < 4; ++j) { ob[64 * j] = (u32x2){pk2(v[j].x, v[j].y), pk2(v[j].z, v[j].w)}; o8[64 * j] = pk4_fp8(v[j].x, v[j].y, v[j].z, v[j].w); }
    if (lane == 0) RSTD2[m] = 1.0f / sqrtf(s * (1.f / D) + EPS);
}
__device__ __forceinline__ void combine_phase(const float* x1, const unsigned char* YS, const int* SLOTTOK, bf16_t* X2B, unsigned char* XF8, float* RSTD2, int G, int vcu, int tid) {
    const int lane = tid & 63, wave = tid >> 6; const int gw = vcu * NWAVES + wave, NGW = G * NWAVES;
    for (int m = gw; m < NTOK; m += 2 * NGW) {
        const int m2 = m + NGW; const bool has2 = m2 < NTOK;
        f32x4 va[4], vb[4]; unsigned ya[4][4], yb[4][4];
        combine_row_load(x1, YS, SLOTTOK, m, lane, va, ya);
        combine_row_load(x1, YS, SLOTTOK, has2 ? m2 : m, lane, vb, yb);
        combine_row_finish(va, ya, X2B, XF8, RSTD2, m, lane);
        if (has2) combine_row_finish(vb, yb, X2B, XF8, RSTD2, m2, lane);
    }
}

__device__ __forceinline__ void final_phase(float* out, const bf16_t* X3B, const float* SSP, const float* __restrict__ ln_final, int G, int vcu, int tid) {
    const int lane = tid & 63, wave = tid >> 6; const int gw = vcu * NWAVES + wave, NGW = G * NWAVES;
    f32x4 gn[4];
#pragma unroll
    for (int j = 0; j < 4; ++j) gn[j] = *((const f32x4*)ln_final + lane + 64 * j);
    for (int m = gw; m < NTOK; m += 2 * NGW) {
        const int m2 = (m + NGW < NTOK) ? m + NGW : m;
        float s = (lane < 16) ? SSP[(size_t)lane * NTOK + m] : 0.f, s2 = (lane < 16) ? SSP[(size_t)lane * NTOK + m2] : 0.f;
        const u32x2* xr = (const u32x2*)(X3B + (size_t)m * D) + lane; const u32x2* xr2 = (const u32x2*)(X3B + (size_t)m2 * D) + lane; u32x2 w[4], w2[4];
#pragma unroll
        for (int j = 0; j < 4; ++j) { w[j] = xr[64 * j]; w2[j] = xr2[64 * j]; }
        s = wave_sum(s); s2 = wave_sum(s2);
        const float rstd = 1.0f / sqrtf(s * (1.f / D) + EPS), rstd2 = 1.0f / sqrtf(s2 * (1.f / D) + EPS);
        f32x4* orow = (f32x4*)(out + (size_t)m * D) + lane; f32x4* orow2 = (f32x4*)(out + (size_t)m2 * D) + lane;
#pragma unroll
        for (int j = 0; j < 4; ++j) { const f32x4 v = (f32x4){bf_lo(w[j].x), bf_hi(w[j].x), bf_lo(w[j].y), bf_hi(w[j].y)}; __builtin_nontemporal_store(v * rstd * gn[j], orow + 64 * j); }
        if (m2 != m) {
#pragma unroll
            for (int j = 0; j < 4; ++j) { const f32x4 v = (f32x4){bf_lo(w2[j].x), bf_hi(w2[j].x), bf_lo(w2[j].y), bf_hi(w2[j].y)}; __builtin_nontemporal_store(v * rstd2 * gn[j], orow2 + 64 * j); } }
    }
}
#ifndef PROBE_VARIANT
#define PROBE_VARIANT 0
#endif
#ifndef MK_N_LAUNCHES
#define MK_N_LAUNCHES 1
#endif
constexpr int N_PHASES = 13;
struct Args { const float* in[20]; float* out; unsigned char* ws; int ph_lo, ph_hi, variant, pad; };
static_assert(sizeof(Args) == 20 * 8 + 8 + 8 + 16, "Args has no padding");

__global__ void __launch_bounds__(NWAVES * 64, 2) fwd_kernel(Args args) {
    extern __shared__ __attribute__((aligned(16))) unsigned char lds_raw[];
    LAS unsigned char* lds = (LAS unsigned char*)lds_raw;
    volatile LAS unsigned* MISC = (volatile LAS unsigned*)(lds + MISC_OFF);
    const int tid = threadIdx.x, G = gridDim.x, bid = blockIdx.x;
    const int vcu = (G % 8 == 0) ? (bid % 8) * (G / 8) + bid / 8 : bid;
    unsigned char* ws = args.ws;
    unsigned* ctl = (unsigned*)(ws + WS_CTL);
    for (int u = tid; u < (LDS_BYTES - MISC_OFF) / 4; u += NWAVES * 64) ((LAS unsigned*)(lds + MISC_OFF))[u] = 0u;
    __syncthreads();
#ifdef PROBE_PREFIX
    const int variant = args.variant;
#else
    constexpr int variant = 0;
#endif
    const int lo = args.ph_lo, hi = args.ph_hi;
    XcdBarrier bar; bar.bar = ctl + CW_BAR; bar.x = 0; bar.st = nullptr;
    if (hi - lo > 1) bar = xcd_barrier_post(ctl + CW_BAR, MISC + 8);
#define IN(k) (lo <= (k) && (k) < hi)
#define TIDP() ({ int t_ = tid; asm volatile("" : "+v"(t_)); t_; })
#define SEAM(k) do { if (IN(k) && IN((k) + 1)) xcd_barrier(bar); } while (0)
    const float* x = args.in[0]; float* out = args.out;
    bf16_t* WIN = (bf16_t*)(ws + WS_WIN);
    bf16_t* XN = (bf16_t*)(ws + WS_XN); bf16_t* OG = (bf16_t*)(ws + WS_OG);
    bf16_t* Z512 = (bf16_t*)(ws + WS_Z512); bf16_t* Z1024 = (bf16_t*)(ws + WS_Z1024);
    bf16_t* QG = Z512; bf16_t* KG = Z512 + (size_t)NTOK * 512; bf16_t* UG = Z512 + (size_t)2 * NTOK * 512;
    bf16_t* RG = Z1024; bf16_t* QA = Z1024 + (size_t)NTOK * D; bf16_t* KA = Z1024 + (size_t)2 * NTOK * D; bf16_t* GA = Z1024 + (size_t)3 * NTOK * D; bf16_t* GBt = Z1024 + (size_t)4 * NTOK * D;
    bf16_t* VT = (bf16_t*)(ws + WS_VT);
    bf16_t* KTT = (bf16_t*)(ws + WS_KTT); float* OGSS = (float*)(ws + WS_OGSS); float* DL = (float*)(ws + WS_DL);
    bf16_t* Hm = (bf16_t*)(ws + WS_H); unsigned char* X1B = ws + WS_X1B;     bf16_t* PP = (bf16_t*)(ws + WS_PP);
    unsigned char* ACT = ws + WS_ACT;     unsigned char* YS = ws + WS_YS;     bf16_t* X2B = (bf16_t*)(ws + WS_X2B);
    unsigned char* rt = ws + WS_RT;
    int* TOPI = (int*)(rt + RT_TOPI); float* TOPW = (float*)(rt + RT_TOPW); float* RSTD1 = (float*)(rt + RT_RSTD1); int* CNT = (int*)(rt + RT_CNT);
    int* TOKSLOT = (int*)(rt + RT_TOKSLOT); float* GATESLOT = (float*)(rt + RT_GATESLOT); float* RSTDSLOT = (float*)(rt + RT_RSTDSLOT); int* SLOTTOK = (int*)(rt + RT_SLOTTOK);
    int* TILEEXP = (int*)(rt + RT_TILEEXP); int* NTILES = (int*)(rt + RT_NTILES); float* RSTD2 = (float*)(rt + RT_RSTD2);
    float* SSP = (float*)(ws + WS_SSP);

    if (IN(0)) {
        P0Args a; a.x = x; a.p = args.in[1]; a.ln_mix = args.in[2]; a.w_in = args.in[3]; a.w_gk = args.in[4]; a.w_out = args.in[8]; a.ln_moe = args.in[9]; a.w_router = args.in[10];
        a.w1 = args.in[12]; a.b1 = args.in[13]; a.w2 = args.in[14]; a.ln_ple = args.in[16]; a.w_pg = args.in[17]; a.w_pp = args.in[18]; a.ws = ws;
        p0_prologue(a, lds, TIDP(), G, vcu);
    }
    SEAM(0);
    if (IN(1)) {
        { pg8::Gemm g{XN, WIN, D}; pg8::StaticOrder S; S.init(NTOK, 6656, G, bid); EpiZ E{Z512, Z1024, (variant & 32) ? 255 : -1}; pg8::gemm_phase(lds, g, S, E, variant); }
        { pg8::Gemm g{WIN + (size_t)6656 * D, XN, D}; pg8::StaticOrder S; S.init(2048, NTOK, G, bid); EpiVT E{VT}; pg8::gemm_phase(lds, g, S, E); }
        { pg8::Gemm g{(const bf16_t*)(ws + WS_PB), (const bf16_t*)(ws + WS_WPP), 256}; pg8::StaticOrder S; S.init(NTOK, D, G, bid); EpiB E{PP, D}; pg8::gemm_phase(lds, g, S, E); }
    }
    SEAM(1);
    if (IN(2)) gla_pre(lds, QG, KG, UG, VT, args.in[5], KTT, DL, OG, G, bid, TIDP());
    SEAM(2);
    if (IN(3)) gla_scan(lds, QG, KTT, VT, DL, OG, OGSS, G, vcu, TIDP(), variant);
    SEAM(3);
    if (IN(4)) attn_phase(lds, QA, KA, VT, OG, RG, GA, GBt, OGSS, args.in[6], args.in[7], Hm, G, vcu, TIDP(), variant);
    SEAM(4);
    if (IN(5)) { pg8::Gemm g{Hm, (const bf16_t*)(ws + WS_WOUT), D}; pg8::StaticOrder S; S.init(NTOK, D, G, bid); EpiX1 E{x, out, X1B}; pg8::gemm_phase(lds, g, S, E); }
    SEAM(5);
    if (IN(6)) router_phase(lds, out, (const bf16_t*)(ws + WS_WRH), (const bf16_t*)(ws + WS_WRL), args.in[11], TOPI, TOPW, RSTD1, CNT, G, bid, TIDP());
    SEAM(6);
    if (IN(7)) assign_phase(lds, TOPI, TOPW, RSTD1, CNT, TOKSLOT, GATESLOT, RSTDSLOT, SLOTTOK, TILEEXP, NTILES, G, bid, TIDP());
    SEAM(7);
    if (IN(8)) { const int ntiles = __builtin_amdgcn_readfirstlane(NTILES[0]);
        pg8::Gemm g{(const bf16_t*)X1B, (const bf16_t*)(ws + WS_W1), D / 2}; pg8::MoeOrder<true> S{TILEEXP, TOKSLOT, ntiles, 8, G, bid}; EpiSwiglu E{RSTDSLOT, (const float*)(ws + WS_B1P), ACT}; pg8::gemm_phase<EpiSwiglu, pg8::MoeOrder<true>, true>(lds, g, S, E, variant); }
    SEAM(8);
    if (IN(9)) { const int ntiles = __builtin_amdgcn_readfirstlane(NTILES[0]);
        pg8::Gemm g{(const bf16_t*)ACT, (const bf16_t*)(ws + WS_W2), D / 2}; pg8::MoeOrder<false> S{TILEEXP, TOKSLOT, ntiles, 4, G, bid}; EpiY E{GATESLOT, args.in[15], YS}; pg8::gemm_phase<EpiY, pg8::MoeOrder<false>, true>(lds, g, S, E); }
    SEAM(9);
    if (IN(10)) combine_phase(out, YS, SLOTTOK, X2B, X1B, RSTD2, G, vcu, TIDP());
    SEAM(10);
    if (IN(11)) { pg8::Gemm g{(const bf16_t*)X1B, (const bf16_t*)(ws + WS_WPG), D / 2}; pg8::StaticOrder S; S.init(NTOK, D, G, bid); EpiPle E{X2B, PP, RSTD2, SSP}; pg8::gemm_phase<EpiPle, pg8::StaticOrder, true>(lds, g, S, E); }
    SEAM(11);
    if (IN(12)) final_phase(out, X2B, SSP, args.in[19], G, vcu, TIDP());
#undef IN
#undef SEAM
}

extern "C" void kernel_launch(void* const* d_in, const int* in_sizes, int n_in, void* d_out, int out_size, void* d_ws, size_t ws_size, hipStream_t stream) {
    static int grid = 0;
    if (grid == 0) {
        if (n_in != 20 || out_size != NTOK * D || ws_size < WS_END) { fprintf(stderr, "kernel_launch: unexpected shapes (n_in %d out %d ws %zu)\n", n_in, out_size, ws_size); grid = -1; return; }
        int dev = 0, cus = 0, per_cu = 0;
        if (hipGetDevice(&dev) != hipSuccess || hipDeviceGetAttribute(&cus, hipDeviceAttributeMultiprocessorCount, dev) != hipSuccess) { grid = -1; return; }
        if (hipFuncSetAttribute((const void*)fwd_kernel, hipFuncAttributeMaxDynamicSharedMemorySize, LDS_BYTES) != hipSuccess) { fprintf(stderr, "kernel_launch: hipFuncSetAttribute failed\n"); grid = -1; return; }
        if (hipOccupancyMaxActiveBlocksPerMultiprocessor(&per_cu, (const void*)fwd_kernel, NWAVES * 64, LDS_BYTES) != hipSuccess || per_cu < 1) { fprintf(stderr, "kernel_launch: occupancy query says %d\n", per_cu); }
        (void)hipGetLastError();
        grid = cus;
    }
    if (grid < 0) return;
    (void)hipMemsetAsync((char*)d_ws + WS_CTL, 0, CTL_ZERO_BYTES, stream);
    Args a{};
    for (int i = 0; i < 20; ++i) a.in[i] = (const float*)d_in[i];
    a.out = (float*)d_out; a.ws = (unsigned char*)d_ws;
#ifdef PROBE_PREFIX
    for (int p = 0; p < PROBE_PREFIX; ++p) { a.ph_lo = p; a.ph_hi = p + 1; a.variant = (p == PROBE_PREFIX - 1) ? PROBE_VARIANT : 0; hipLaunchKernelGGL(fwd_kernel, dim3(grid), dim3(NWAVES * 64), LDS_BYTES, stream, a); }
    a.variant = 0;
#endif
#if MK_N_LAUNCHES == 1
    a.ph_lo = 0; a.ph_hi = N_PHASES;
    hipLaunchKernelGGL(fwd_kernel, dim3(grid), dim3(NWAVES * 64), LDS_BYTES, stream, a);
#else
    for (int p = 0; p < N_PHASES; ++p) { a.ph_lo = p; a.ph_hi = p + 1; hipLaunchKernelGGL(fwd_kernel, dim3(grid), dim3(NWAVES * 64), LDS_BYTES, stream, a); }
#endif
}
```

```cpp
#define MK_N_LAUNCHES 1
#include <hip/hip_runtime.h>
#include <cstdio>
#include <cstdint>

#define GAS __attribute__((address_space(1)))
#define LAS __attribute__((address_space(3)))
typedef unsigned short bf16_t;
typedef short bf16x8 __attribute__((ext_vector_type(8)));
typedef short s16x4 __attribute__((ext_vector_type(4)));
typedef float f32x4 __attribute__((ext_vector_type(4)));
typedef float f32x2 __attribute__((ext_vector_type(2)));
typedef float f32x16 __attribute__((ext_vector_type(16)));
typedef unsigned u32x4 __attribute__((ext_vector_type(4)));
typedef unsigned u32x2 __attribute__((ext_vector_type(2)));
typedef __bf16 bf16x2_t __attribute__((ext_vector_type(2)));
typedef int v8i_t __attribute__((ext_vector_type(8)));
__device__ __forceinline__ unsigned pk4_fp8(float a, float b, float c, float d) { int w = __builtin_amdgcn_cvt_pk_fp8_f32(a, b, 0, false); w = __builtin_amdgcn_cvt_pk_fp8_f32(c, d, w, true); return (unsigned)w; }

__device__ __forceinline__ unsigned pk2(float lo, float hi) { f32x2 v = {lo, hi}; bf16x2_t b = __builtin_convertvector(v, bf16x2_t); return __builtin_bit_cast(unsigned, b); }
__device__ __forceinline__ float bf_lo(unsigned w) { return __uint_as_float(w << 16); }
__device__ __forceinline__ float bf_hi(unsigned w) { return __uint_as_float(w & 0xffff0000u); }
__device__ __forceinline__ float fast_exp2(float x) { return __builtin_amdgcn_exp2f(x); }
__device__ __forceinline__ float fast_rcp(float x) { return __builtin_amdgcn_rcpf(x); }
__device__ __forceinline__ float sigmoidf_(float x) { return fast_rcp(1.0f + fast_exp2(-1.4426950408889634f * x)); }

namespace pg8 {
constexpr int BM = 256, BK = 64, HALF = 128, HTB = HALF * BK * 2, STAGE_BYTES = 8 * HTB, NXCD = 8, WGM = 8;
__host__ __device__ __forceinline__ int lds_byte(int r, int c) { const int st = (r >> 4) * 2 + (c >> 5), rr = r & 15, cc = c & 31, ob = rr * 64 + cc * 2; return st * 1024 + (ob ^ (((ob >> 9) & 1) << 5)); }
__host__ __device__ __forceinline__ void stage_rc(int b, int& R, int& C) { const int st = b / 1024, sb = b % 1024, swz = sb ^ (((sb >> 9) & 1) << 5); R = (st >> 1) * 16 + swz / 64; C = (st & 1) * 32 + (swz % 64) / 2; }
__host__ __device__ __forceinline__ int perm32(int rho) { const int n = rho >> 4, i = rho & 15; return 8 * (i >> 2) + 4 * n + (i & 3); }

struct Unit { int pm, pn; };
struct Gemm { const bf16_t* A; const bf16_t* Bt; int K; };

struct StaticOrder {
    int nM, nN, nwg, G, c;
    __device__ __forceinline__ void init(int M, int N, int G_, int c_) { nM = M / BM; nN = N / BM; nwg = nM * nN; G = G_; c = c_; }
    __device__ __forceinline__ bool next(int i, Unit& u) const {
        const long L = (long)i * G + c; if (L >= nwg) return false;
        int wgid = (int)L; { const int q = nwg / NXCD, r = nwg % NXCD, xcd = wgid % NXCD, off = wgid / NXCD; wgid = (xcd < r ? xcd * (q + 1) : r * (q + 1) + (xcd - r) * q) + off; }
        const int nig = WGM * nN, gid = wgid / nig, fm = gid * WGM, gsz = (nM - fm) < WGM ? (nM - fm) : WGM;
        u.pm = fm + ((wgid % nig) % gsz); u.pn = (wgid % nig) / gsz; return true;
    }
    __device__ __forceinline__ unsigned arow(const Unit& u, int r, int K) const { return (unsigned)((u.pm * BM + r) * K) * 2u; }
};
template <bool GATHER> struct MoeOrder {
    const int* tile_expert; const int* rowmap; int ntiles, NT, G, c;
    __device__ __forceinline__ bool next(int i, Unit& u) const {
        const int nx = G >> 3, x = c & 7, y = c >> 3, tper = (ntiles + 7) >> 3, mt0 = x * tper;
        const int q = i * nx + y, ml = q / NT, mt = mt0 + ml;
        if (ml >= tper || mt >= ntiles) return false;
        u.pm = mt; u.pn = __builtin_amdgcn_readfirstlane(tile_expert[mt]) * NT + (q - ml * NT); return true;
    }
    __device__ __forceinline__ unsigned arow(const Unit& u, int r, int K) const {
        if (GATHER) return (unsigned)(rowmap[u.pm * BM + r] * K) * 2u;
        return (unsigned)((u.pm * BM + r) * K) * 2u;
    }
};

template <class Epi, class Sched, bool FP8 = false>
__device__ __forceinline__ void gemm_phase(LAS unsigned char* lds, const Gemm g, const Sched& S, const Epi& E, int variant = 0) {
    int tid_ = threadIdx.x; asm volatile("" : "+v"(tid_));
    const int tid = tid_, wid = __builtin_amdgcn_readfirstlane(tid >> 6), lane = tid & 63, wr = wid >> 2, wc = wid & 3, fr = lane & 15, fq = lane >> 4;
    int K_ = (variant & 8) ? (g.K >> 1) : g.K; asm volatile("" : "+s"(K_));
    const int K = K_, nt = K / BK;
    int RA[2], CA[2]; unsigned voffB[2];
#pragma unroll
    for (int i = 0; i < 2; ++i) { int R, C; stage_rc(tid * 16 + i * 8192, R, C); const int Rb = Epi::PERM ? ((R & ~31) + perm32(R & 31)) : R;
        RA[i] = R; CA[i] = C * 2; voffB[i] = (unsigned)(Rb * K + C) * 2u; }
    const size_t kstep = (size_t)(BK * 2);
    const size_t hstep = (size_t)HALF * K * 2;
    const size_t tstep = 2 * hstep;
    const unsigned ldsw = (unsigned)wid * 1024u;
    const int aoff = lds_byte(wr * 64 + fr, fq * 8), boff = lds_byte(wc * 32 + fr, fq * 8);
#define PG8_SA(b, h) (((b) * 2 + (h)) * HTB)
#define PG8_SB(b, h) ((4 + (b) * 2 + (h)) * HTB)
#define PG8_STAGE(bufoff, gbase, voff) do { _Pragma("unroll") for (int _i = 0; _i < 2; ++_i) \
        __builtin_amdgcn_global_load_lds((const unsigned*)((const char*)(gbase) + (voff)[_i]), (LAS unsigned*)(lds + (bufoff) + ldsw + _i * 8192), 16, 0, 0); } while (0)
#define PG8_LDA(dst, b, h) do { _Pragma("unroll") for (int m = 0; m < 4; ++m) _Pragma("unroll") for (int k = 0; k < 2; ++k) dst[m][k] = *(const LAS bf16x8*)(lds + PG8_SA(b, h) + aoff + m * 2048 + k * 1024); } while (0)
#define PG8_LDB(dst, b, h) do { _Pragma("unroll") for (int n = 0; n < 2; ++n) _Pragma("unroll") for (int k = 0; k < 2; ++k) dst[n][k] = *(const LAS bf16x8*)(lds + PG8_SB(b, h) + boff + n * 2048 + k * 1024); } while (0)
#define PG8_CAT(a, b) __builtin_bit_cast(v8i_t, __builtin_shufflevector((a), (b), 0, 1, 2, 3, 4, 5, 6, 7, 8, 9, 10, 11, 12, 13, 14, 15))
#define PG8_MMA(ai, bj, At, Bt) do { __builtin_amdgcn_s_setprio(1); \
        if constexpr (FP8) { _Pragma("unroll") for (int m = 0; m < 4; ++m) _Pragma("unroll") for (int n = 0; n < 2; ++n) \
            acc[ai][bj][m][n] = __builtin_amdgcn_mfma_scale_f32_16x16x128_f8f6f4(PG8_CAT(Bt[n][0], Bt[n][1]), PG8_CAT(At[m][0], At[m][1]), acc[ai][bj][m][n], 0, 0, 0, 0, 0, 0);     } \
        else { _Pragma("unroll") for (int m = 0; m < 4; ++m) _Pragma("unroll") for (int n = 0; n < 2; ++n) _Pragma("unroll") for (int k = 0; k < 2; ++k) \
            acc[ai][bj][m][n] = __builtin_amdgcn_mfma_f32_16x16x32_bf16(Bt[n][k], At[m][k], acc[ai][bj][m][n], 0, 0, 0); } \
        __builtin_amdgcn_s_setprio(0); } while (0)
#define PG8_WAIT_V(n) asm volatile("s_waitcnt vmcnt(" #n ")" ::: "memory")
#define PG8_WAIT_L(n) asm volatile("s_waitcnt lgkmcnt(" #n ")" ::: "memory")
#define PG8_BAR __builtin_amdgcn_s_barrier()
#define PG8_SCHED __builtin_amdgcn_sched_barrier(0)
    Unit cur, nxt; int ui = 0;
    if (!S.next(0, cur)) return;
    f32x4 acc[2][2][4][2];
#pragma unroll
    for (int a = 0; a < 2; ++a)
#pragma unroll
        for (int b = 0; b < 2; ++b)
#pragma unroll
            for (int m = 0; m < 4; ++m)
#pragma unroll
                for (int n = 0; n < 2; ++n) acc[a][b][m][n] = (f32x4){0.f, 0.f, 0.f, 0.f};
    bf16x8 At[4][2], B0[2][2], B1[2][2];
    unsigned vA0[2], vA1[2];
#pragma unroll
    for (int i = 0; i < 2; ++i) { vA0[i] = S.arow(cur, RA[i], K) + (unsigned)CA[i]; vA1[i] = S.arow(cur, HALF + RA[i], K) + (unsigned)CA[i]; }
    const char* const Ab = (const char*)g.A;
    const char* cB = (const char*)g.Bt + (size_t)cur.pn * tstep;
    PG8_STAGE(PG8_SB(0, 0), cB, voffB); PG8_STAGE(PG8_SB(0, 1), cB + hstep, voffB); PG8_STAGE(PG8_SA(0, 0), Ab, vA0); PG8_STAGE(PG8_SA(0, 1), Ab, vA1);
    if (wr == 1) PG8_BAR;
    PG8_WAIT_V(2); PG8_BAR;
    PG8_STAGE(PG8_SB(1, 0), cB + kstep, voffB); PG8_STAGE(PG8_SA(1, 0), Ab + kstep, vA0); PG8_STAGE(PG8_SB(1, 1), cB + hstep + kstep, voffB);
    PG8_WAIT_V(6); PG8_BAR;
    for (;;) {
        const bool has_next = S.next(ui + 1, nxt);
        const char* nB = has_next ? (const char*)g.Bt + (size_t)nxt.pn * tstep : cB;
        for (int t = 0; t < nt; t += 2) {
            const bool last = (t == nt - 2);
            const char* a1 = Ab + (size_t)(t + 1) * kstep;
            const char* a2 = last ? Ab : Ab + (size_t)(t + 2) * kstep; const char* b2 = last ? nB : cB + (size_t)(t + 2) * kstep;
            const char* a3 = a2 + kstep; const char* b3 = b2 + kstep;
            PG8_LDB(B0, 0, 0); PG8_LDB(B1, 0, 1); PG8_SCHED; PG8_LDA(At, 0, 0); PG8_STAGE(PG8_SA(1, 1), a1, vA1);
            if (last && has_next) {
#pragma unroll
                for (int i = 0; i < 2; ++i) { vA0[i] = S.arow(nxt, RA[i], K) + (unsigned)CA[i]; vA1[i] = S.arow(nxt, HALF + RA[i], K) + (unsigned)CA[i]; }
            }
            PG8_WAIT_V(8); PG8_WAIT_L(0); PG8_BAR; PG8_MMA(0, 0, At, B0); PG8_MMA(0, 1, At, B1); PG8_BAR; PG8_SCHED;
            PG8_LDA(At, 0, 1); PG8_STAGE(PG8_SB(0, 0), b2, voffB); PG8_STAGE(PG8_SB(0, 1), b2 + hstep, voffB); PG8_STAGE(PG8_SA(0, 0), a2, vA0);
            PG8_WAIT_V(8); PG8_WAIT_L(0); PG8_BAR; PG8_MMA(1, 0, At, B0); PG8_MMA(1, 1, At, B1); PG8_BAR; PG8_SCHED;
            PG8_LDB(B0, 1, 0); PG8_LDB(B1, 1, 1); PG8_SCHED; PG8_LDA(At, 1, 0); PG8_STAGE(PG8_SA(0, 1), a2, vA1);
            PG8_WAIT_V(8); PG8_WAIT_L(0); PG8_BAR; PG8_MMA(0, 0, At, B0); PG8_MMA(0, 1, At, B1); PG8_BAR; PG8_SCHED;
            PG8_LDA(At, 1, 1); PG8_STAGE(PG8_SB(1, 0), b3, voffB); PG8_STAGE(PG8_SB(1, 1), b3 + hstep, voffB); PG8_STAGE(PG8_SA(1, 0), a3, vA0);
            PG8_WAIT_V(8); PG8_WAIT_L(0); PG8_BAR; PG8_MMA(1, 0, At, B0); PG8_MMA(1, 1, At, B1); PG8_BAR; PG8_SCHED;
        }
        if (wr == 0) PG8_BAR;
        if (!(variant & 16)) E(acc, cur, wr, wc, fr, fq);
        if (!has_next) break;
#pragma unroll
        for (int a = 0; a < 2; ++a)
#pragma unroll
            for (int b = 0; b < 2; ++b)
#pragma unroll
                for (int m = 0; m < 4; ++m)
#pragma unroll
                    for (int n = 0; n < 2; ++n) acc[a][b][m][n] = (f32x4){0.f, 0.f, 0.f, 0.f};
        cur = nxt; cB = nB; ++ui;
        if (wr == 1) PG8_BAR;
    }
    PG8_WAIT_V(0);
    PG8_BAR;
#undef PG8_SA
#undef PG8_SB
#undef PG8_STAGE
#undef PG8_LDA
#undef PG8_LDB
#undef PG8_MMA
#undef PG8_CAT
#undef PG8_WAIT_V
#undef PG8_WAIT_L
#undef PG8_BAR
#undef PG8_SCHED
}
}
constexpr int NB = 8, TSEQ = 4096, NTOK = NB * TSEQ, D = 1024, NCH = 64;
constexpr int NEXP = 32, NSLOT = NTOK * 4 + NEXP * 256;
constexpr float EPS = 1e-6f;
constexpr float LOG2E = 1.4426950408889634f;
constexpr int NWAVES = 8;
constexpr float WSCALE = 64.0f, ASCALE = 4.0f, YSCALE = 16.0f;

constexpr size_t MiB = 1u << 20, KiB = 1u << 10;
constexpr size_t WS_CTL = 0, CTL_ZERO_BYTES = 1 * MiB;
constexpr size_t WS_WIN = 2 * MiB;
constexpr size_t WS_WOUT = 19 * MiB, WS_WPG = 21 * MiB, WS_WPP = 23 * MiB;
constexpr size_t WS_WRH = 23 * MiB + 512 * KiB, WS_WRL = WS_WRH + 64 * KiB, WS_B1P = 23 * MiB + 768 * KiB;
constexpr size_t WS_W1 = 24 * MiB, WS_W2 = 152 * MiB;
constexpr size_t WS_XN = 216 * MiB;
constexpr size_t WS_OG = WS_XN;
constexpr size_t WS_X2B = WS_XN;
constexpr size_t WS_PP = 280 * MiB;
constexpr size_t WS_X1B = 344 * MiB;
constexpr size_t WS_PB = 408 * MiB;
constexpr size_t WS_SSP = WS_PB;
constexpr size_t WS_RT = 424 * MiB;
constexpr size_t WS_Z512 = 432 * MiB;
constexpr size_t WS_Z1024 = 528 * MiB;
constexpr size_t WS_VT = 848 * MiB;
constexpr size_t WS_KTT = 976 * MiB;
constexpr size_t WS_OGSS = 1008 * MiB;
constexpr size_t WS_DL = 1016 * MiB;
constexpr size_t WS_END = 1018 * MiB;
constexpr size_t WS_H = WS_Z512;
constexpr size_t WS_ACT = 432 * MiB;
constexpr size_t WS_YS = 704 * MiB;
static_assert(WS_ACT + (size_t)NSLOT * 2048 <= WS_YS && WS_YS + (size_t)NSLOT * 2048 <= WS_KTT, "MoE overlays");
constexpr size_t RT_TOPI = 0, RT_TOPW = 512 * KiB, RT_RSTD1 = 1 * MiB, RT_CNT = 1 * MiB + 128 * KiB;
constexpr size_t RT_TOKSLOT = 2 * MiB, RT_GATESLOT = 3 * MiB, RT_RSTDSLOT = 4 * MiB, RT_SLOTTOK = 5 * MiB, RT_TILEEXP = 6 * MiB, RT_NTILES = 6 * MiB + 8 * KiB, RT_RSTD2 = 6 * MiB + 64 * KiB;
constexpr int CW_TMO = 0, CW_CODE = 1, CW_BAR = 4096;

constexpr int RING_BYTES = 131072, ATT_BT_OFF = 131072, MISC_OFF = 131072 + 24576, LDS_BYTES = 131072 + 24576 + 512;

#define RLX_AGENT __ATOMIC_RELAXED, __HIP_MEMORY_SCOPE_AGENT

#define XB_TMO      128
#define XB_XCNT(j)  (256  + 64 * (j))
#define XB_XSUB(j)  (1280 + 64 * (j))
#define XB_XGEN(j)  (2304 + 64 * (j))
#define XB_TOP      3328
#define XB_TOPGEN   3392
#define XCD_BAR_WORDS 3456
#define XB_SPIN_CAP (1u << 18)
__device__ __forceinline__ unsigned xb_ld(unsigned* p)              { return __hip_atomic_load(p, __ATOMIC_RELAXED, __HIP_MEMORY_SCOPE_AGENT); }
__device__ __forceinline__ unsigned xb_add(unsigned* p, unsigned v) { return __hip_atomic_fetch_add(p, v, __ATOMIC_RELAXED, __HIP_MEMORY_SCOPE_AGENT); }
__device__ __forceinline__ unsigned xb_xcc_id() { return (unsigned)__builtin_amdgcn_s_getreg((3 << 11) | 20) & 0xFu; }
#define XB_SPIN(cond, bar) do { unsigned _sp = 0; while (cond) { __builtin_amdgcn_s_sleep(1); \
    if ((++_sp & 255u) == 0u) { if (xb_ld(&(bar)[XB_TMO])) break; if (_sp > XB_SPIN_CAP) { atomicAdd(&(bar)[XB_TMO], 1u); break; } } } } while (0)
struct XcdBarrier { unsigned* bar; unsigned x; volatile LAS unsigned* st; };
__device__ __forceinline__ XcdBarrier xcd_barrier_post(unsigned* bar, volatile LAS unsigned* st) {
    XcdBarrier b; b.bar = bar; b.x = xb_xcc_id(); b.st = st;
    if (threadIdx.x == 0) (void)xb_add(&bar[XB_XCNT(b.x)], 1u);
    return b;
}
__device__ __forceinline__ void xcd_barrier_complete(unsigned* bar, unsigned x, unsigned& nloc, unsigned& nx) {
    const unsigned G = gridDim.x * gridDim.y * gridDim.z;
    unsigned sum, cnt, mine, sp = 0u;
    for (;;) {
        sum = 0u; cnt = 0u; mine = 0u;
#pragma unroll
        for (unsigned j = 0; j < 16; ++j) { const unsigned c = xb_ld(&bar[XB_XCNT(j)]); sum += c; cnt += (c > 0u) ? 1u : 0u; mine = (j == x) ? c : mine; }
        if (sum == G) break;
        __builtin_amdgcn_s_sleep(1);
        if ((++sp & 255u) == 0u) { if (xb_ld(&bar[XB_TMO])) break; if (sp > XB_SPIN_CAP) { atomicAdd(&bar[XB_TMO], 1u); break; } }
    }
    nloc = mine > 0u ? mine : 1u; nx = cnt > 0u ? cnt : 1u;
}
__device__ __forceinline__ void xcd_barrier(const XcdBarrier& b) {
    asm volatile("s_waitcnt vmcnt(0)" ::: "memory");
    __syncthreads();
    if (threadIdx.x == 0) {
        unsigned* bar = b.bar;
        __builtin_amdgcn_s_waitcnt(0);
        unsigned nloc = b.st[0], nx = b.st[1];
        if (nloc == 0u) { xcd_barrier_complete(bar, b.x, nloc, nx); b.st[0] = nloc; b.st[1] = nx; }
        const unsigned old = xb_add(&bar[XB_XSUB(b.x)], 1u);
        const unsigned gen = old / nloc;
        if (old + 1u == (gen + 1u) * nloc) {
            __builtin_amdgcn_fence(__ATOMIC_RELEASE, "agent");
            asm volatile("s_waitcnt vmcnt(0)" ::: "memory");
            const unsigned og = xb_add(&bar[XB_TOP], 1u);
            const unsigned tg = og / nx;
            if (og + 1u == (tg + 1u) * nx) xb_add(&bar[XB_TOPGEN], 1u);
            else XB_SPIN(xb_ld(&bar[XB_TOPGEN]) == tg, bar);
            __builtin_amdgcn_fence(__ATOMIC_ACQUIRE, "agent");
            xb_add(&bar[XB_XGEN(b.x)], 1u);
            asm volatile("s_waitcnt vmcnt(0)" ::: "memory");
        } else {
            XB_SPIN(xb_ld(&bar[XB_XGEN(b.x)]) == gen, bar);
            __builtin_amdgcn_fence(__ATOMIC_ACQUIRE, "agent");
            asm volatile("s_waitcnt vmcnt(0)" ::: "memory");
        }
    }
    __syncthreads();
}

__device__ __forceinline__ float wave_sum(float v) {
#pragma unroll
    for (int o = 1; o < 64; o <<= 1) v += __shfl_xor(v, o);
    return v;
}
#define MFMA16(a, b, c) __builtin_amdgcn_mfma_f32_16x16x32_bf16((a), (b), (c), 0, 0, 0)
#define MFMA32(a, b, c) __builtin_amdgcn_mfma_f32_32x32x16_bf16((a), (b), (c), 0, 0, 0)
struct TJob { const float* W; bf16_t* WT; const float* gain; float scale; int ldw, Kd, nblk, kblk, scol, dbase, mode, start, nbatch; long sstride, dstride; };
constexpr int NJOBS = 14;
__device__ __forceinline__ int tj_drow(int mode, int dbase, int n) { if (!(mode & 1)) return dbase + n; const int f = n >> 1, s = n & 1; return 256 * (f >> 7) + 128 * s + (f & 127); }
struct TRegs { f32x4 a[8], b[8]; };
__device__ __forceinline__ void tj_decode(const LAS TJob* jobs, int it, const float*& W, bf16_t*& WT, const float*& gain, float& scale, int& ldw, int& Kd, int& k0, int& n0, int& scol, int& dbase, int& mode) {
    int j = 0;
#pragma unroll 1
    for (int q = 1; q < NJOBS; ++q) if (it >= jobs[q].start) j = q;
    const LAS TJob& J = jobs[j]; int local = it - J.start; const int per = J.nblk * J.kblk; const int bt = local / per; local -= bt * per; const int kb = local / J.nblk, nb = local - kb * J.nblk;
    W = J.W + bt * J.sstride; WT = (bf16_t*)((char*)J.WT + bt * J.dstride); gain = J.gain; scale = J.scale; ldw = J.ldw; Kd = J.Kd; k0 = 64 * kb; n0 = 64 * nb; scol = J.scol; dbase = J.dbase; mode = J.mode;
}
#define TJ_LOAD(R, W, ldw, k0, scolx, lane, mode) do { const int rp_ = (lane) >> 4, c4_ = (lane) & 15; \
    _Pragma("unroll") for (int i = 0; i < 8; ++i) { const int P_ = ((mode) & 2) ? (8 * (i >> 1) + 2 * rp_ + (i & 1)) : (4 * i + rp_); const float* s_ = (W) + (size_t)((k0) + 2 * P_) * (ldw) + (scolx) + 4 * c4_; (R).a[i] = __builtin_nontemporal_load((const f32x4*)s_); (R).b[i] = __builtin_nontemporal_load((const f32x4*)(s_ + (ldw))); } } while (0)
__device__ __forceinline__ void tj_process(const TRegs& R, bf16_t* WT, int Kd, const float* gain, float scale, int k0, int n0, int dbase, int mode, LAS unsigned* scr, int lane) {
    const int rp = lane >> 4, c4 = lane & 15;
    if (mode & 2) {
        const int swz = 4 * (c4 & 3);
#pragma unroll
        for (int u = 0; u < 4; ++u) { const int Q = 4 * u + rp; float g0 = scale, g1 = scale, g2 = scale, g3 = scale;
            if (gain) { const f32x4 gv = *(const f32x4*)(gain + k0 + 4 * Q); g0 *= gv[0]; g1 *= gv[1]; g2 *= gv[2]; g3 *= gv[3]; }
#pragma unroll
            for (int t = 0; t < 4; ++t) scr[(4 * c4 + t) * 16 + (Q ^ swz)] = pk4_fp8(R.a[2 * u][t] * g0, R.b[2 * u][t] * g1, R.a[2 * u + 1][t] * g2, R.b[2 * u + 1][t] * g3); }
        asm volatile("s_waitcnt lgkmcnt(0)" ::: "memory");
#pragma unroll
        for (int j = 0; j < 4; ++j) { const int n = (lane >> 2) + 16 * j, ch = lane & 3; const u32x4 v = *(const LAS u32x4*)(scr + n * 16 + ((4 * ch) ^ (4 * ((n >> 2) & 3))));
            __builtin_nontemporal_store(v, (u32x4*)((char*)WT + (size_t)tj_drow(mode, dbase, n0 + n) * Kd + k0 + 16 * ch)); }
        asm volatile("s_waitcnt lgkmcnt(0)" ::: "memory");
        return;
    }
    const int swz = 4 * (c4 & 7);
#pragma unroll
    for (int i = 0; i < 8; ++i) { const int P = 4 * i + rp; float g0 = scale, g1 = scale; if (gain) { g0 *= gain[k0 + 2 * P]; g1 *= gain[k0 + 2 * P + 1]; }
#pragma unroll
        for (int t = 0; t < 4; ++t) scr[(4 * c4 + t) * 32 + (P ^ swz)] = pk2(R.a[i][t] * g0, R.b[i][t] * g1); }
    asm volatile("s_waitcnt lgkmcnt(0)" ::: "memory");
#pragma unroll
    for (int j = 0; j < 8; ++j) { const int n = (lane >> 3) + 8 * j, ch = lane & 7; const u32x4 v = *(const LAS u32x4*)(scr + n * 32 + ((4 * ch) ^ (4 * ((n >> 2) & 7))));
        *(u32x4*)(WT + (size_t)tj_drow(mode, dbase, n0 + n) * Kd + k0 + 8 * ch) = v; }
    asm volatile("s_waitcnt lgkmcnt(0)" ::: "memory");
}

struct P0Args { const float *x, *p, *ln_mix, *w_in, *w_gk, *w_out, *ln_moe, *w_router, *w1, *b1, *w2, *ln_ple, *w_pg, *w_pp; unsigned char* ws; };

__device__ __forceinline__ void p0_prologue(const P0Args& a, LAS unsigned char* lds, int tid, int G, int vcu) {
    const int lane = tid & 63, wave = __builtin_amdgcn_readfirstlane(tid >> 6);
    LAS unsigned* scr = (LAS unsigned*)(lds + wave * 8192);
    LAS TJob* jobs = (LAS TJob*)(lds + 65536);
    const int gw = vcu * NWAVES + wave, NGW = G * NWAVES;
    bf16_t* WIN = (bf16_t*)(a.ws + WS_WIN);
    constexpr int DIN = 8208;
    const float C2 = 0.125f * LOG2E, QGS = 0.08838834764831845f;
    if (tid == 0) {
        int st = 0;
        auto add = [&](int j, const float* W, bf16_t* WT, const float* gain, float scale, int ldw, int Kd, int ncols, int Krows, int scol, int dbase, int mode, int nbatch, long ss, long ds) {
            LAS TJob* J = jobs + j; J->W = W; J->WT = WT; J->gain = gain; J->scale = scale; J->ldw = ldw; J->Kd = Kd; J->nblk = ncols / 64; J->kblk = Krows / 64; J->scol = scol; J->dbase = dbase; J->mode = mode; J->start = st; J->nbatch = nbatch; J->sstride = ss; J->dstride = ds;
            st += (ncols / 64) * (Krows / 64) * nbatch; };
        add(0, a.w1, (bf16_t*)(a.ws + WS_W1), a.ln_moe, WSCALE, 2048, D, 2048, D, 0, 0, 3, NEXP, (long)D * 2048, (long)2048 * D);
        add(1, a.w2, (bf16_t*)(a.ws + WS_W2), nullptr, WSCALE, D, D, D, D, 0, 0, 2, NEXP, (long)D * D, (long)D * D);
        add(2, a.w_in, WIN, a.ln_mix, QGS, DIN, D, 512, D, 0, 0, 0, 1, 0, 0);
        add(3, a.w_in, WIN, a.ln_mix, 1.f, DIN, D, 512, D, 512, 512, 0, 1, 0, 0);
        add(4, a.w_in, WIN, a.ln_mix, 1.f, DIN, D, 1024, D, 2064, 1536, 0, 1, 0, 0);
        add(5, a.w_in, WIN, a.ln_mix, C2, DIN, D, 1024, D, 3088, 2560, 0, 1, 0, 0);
        add(6, a.w_in, WIN, a.ln_mix, 1.f, DIN, D, 1024, D, 4112, 3584, 0, 1, 0, 0);
        add(7, a.w_in, WIN, a.ln_mix, 1.f, DIN, D, 1024, D, 6160, 4608, 0, 1, 0, 0);
        add(8, a.w_in, WIN, a.ln_mix, 1.f, DIN, D, 1024, D, 7184, 5632, 0, 1, 0, 0);
        add(9, a.w_in, WIN, a.ln_mix, 1.f, DIN, D, 1024, D, 1024, 6656, 0, 1, 0, 0);
        add(10, a.w_in, WIN, a.ln_mix, 1.f, DIN, D, 1024, D, 5136, 7680, 0, 1, 0, 0);
        add(11, a.w_out, (bf16_t*)(a.ws + WS_WOUT), nullptr, 1.f, D, D, D, D, 0, 0, 0, 1, 0, 0);
        add(12, a.w_pg, (bf16_t*)(a.ws + WS_WPG), a.ln_ple, WSCALE, D, D, D, D, 0, 0, 2, 1, 0, 0);
        add(13, a.w_pp, (bf16_t*)(a.ws + WS_WPP), nullptr, 1.f, D, 256, D, 256, 0, 0, 0, 1, 0, 0);
        *(LAS int*)(lds + 65536 + 2048) = st;
    }
    __syncthreads();
    const int nitems = *(LAS int*)(lds + 65536 + 2048);
    {
        TRegs RA, RB; const float *Wa, *ga, *Wb, *gb; bf16_t *Ta, *Tb; float sa, sb; int la, Ka, k0a, n0a, sca, dba, ma, lb, Kb, k0b, n0b, scb, dbb, mb;
        int it = gw;
        if (it < nitems) { tj_decode(jobs, it, Wa, Ta, ga, sa, la, Ka, k0a, n0a, sca, dba, ma); TJ_LOAD(RA, Wa, la, k0a, sca + n0a, lane, ma); }
        while (it < nitems) {
            int nx = it + NGW;
            if (nx < nitems) { tj_decode(jobs, nx, Wb, Tb, gb, sb, lb, Kb, k0b, n0b, scb, dbb, mb); TJ_LOAD(RB, Wb, lb, k0b, scb + n0b, lane, mb); }
            tj_process(RA, Ta, Ka, ga, sa, k0a, n0a, dba, ma, scr, lane);
            it = nx; if (it >= nitems) break;
            nx = it + NGW;
            if (nx < nitems) { tj_decode(jobs, nx, Wa, Ta, ga, sa, la, Ka, k0a, n0a, sca, dba, ma); TJ_LOAD(RA, Wa, la, k0a, sca + n0a, lane, ma); }
            tj_process(RB, Tb, Kb, gb, sb, k0b, n0b, dbb, mb, scr, lane);
            it = nx;
        }
    }
    const int gt = vcu * (NWAVES * 64) + tid, NGT = G * NWAVES * 64;
    for (int idx = gt; idx < 512 * D; idx += NGT) { const int n = idx >> 10, k = idx & 1023; const float* wr = a.w_in + (size_t)k * DIN + 2048; float s = 0.f;
#pragma unroll
        for (int r = 0; r < 16; ++r) s += wr[r] * a.w_gk[r * 512 + n];
        WIN[(size_t)(1024 + n) * D + k] = (bf16_t)(pk2(s * a.ln_mix[k], 0.f) & 0xffffu); }
    { bf16_t* WRH = (bf16_t*)(a.ws + WS_WRH); bf16_t* WRL = (bf16_t*)(a.ws + WS_WRL);
      for (int idx = gt; idx < NEXP * D; idx += NGT) { const int e = idx >> 10, k = idx & 1023; const float v = a.w_router[k * NEXP + e] * a.ln_moe[k];
          const unsigned h = pk2(v, 0.f) & 0xffffu; const float lo = v - __uint_as_float(h << 16); WRH[idx] = (bf16_t)h; WRL[idx] = (bf16_t)(pk2(lo, 0.f) & 0xffffu); } }
    { float* B1P = (float*)(a.ws + WS_B1P);
      for (int idx = gt; idx < NEXP * 2048; idx += NGT) { const int e = idx >> 11, r = idx & 2047, t = r >> 8, s = (r >> 7) & 1, j = r & 127; B1P[idx] = a.b1[e * 2048 + 2 * (128 * t + j) + s]; } }
    { bf16_t* XN = (bf16_t*)(a.ws + WS_XN);
      for (int m = gw; m < NTOK; m += 2 * NGW) { const int m2 = m + NGW; const bool has2 = m2 < NTOK;
          const f32x4* xr = (const f32x4*)(a.x + (size_t)m * D) + lane; const f32x4* xr2 = (const f32x4*)(a.x + (size_t)(has2 ? m2 : m) * D) + lane; f32x4 v[4], w[4]; float s = 0.f, s2 = 0.f;
#pragma unroll
          for (int j = 0; j < 4; ++j) { v[j] = __builtin_nontemporal_load(xr + 64 * j); w[j] = __builtin_nontemporal_load(xr2 + 64 * j); }
#pragma unroll
          for (int j = 0; j < 4; ++j) { s += (v[j].x * v[j].x + v[j].y * v[j].y) + (v[j].z * v[j].z + v[j].w * v[j].w); s2 += (w[j].x * w[j].x + w[j].y * w[j].y) + (w[j].z * w[j].z + w[j].w * w[j].w); }
          const float rstd = 1.0f / sqrtf(wave_sum(s) * (1.f / D) + EPS), rstd2 = 1.0f / sqrtf(wave_sum(s2) * (1.f / D) + EPS);
          u32x2* o8 = (u32x2*)(XN + (size_t)m * D) + lane;
#pragma unroll
          for (int j = 0; j < 4; ++j) o8[64 * j] = (u32x2){pk2(v[j].x * rstd, v[j].y * rstd), pk2(v[j].z * rstd, v[j].w * rstd)};
          if (has2) { u32x2* o9 = (u32x2*)(XN + (size_t)m2 * D) + lane;
#pragma unroll
              for (int j = 0; j < 4; ++j) o9[64 * j] = (u32x2){pk2(w[j].x * rstd2, w[j].y * rstd2), pk2(w[j].z * rstd2, w[j].w * rstd2)}; } } }
    { u32x2* PB = (u32x2*)(a.ws + WS_PB); const f32x4* p4 = (const f32x4*)a.p;
      for (int i = gt; i < NTOK * 256 / 4; i += NGT) { const f32x4 v = __builtin_nontemporal_load(p4 + i); PB[i] = (u32x2){pk2(v.x, v.y), pk2(v.z, v.w)}; } }
}

struct EpiZ {
    static constexpr bool PERM = true;
    bf16_t* z512; bf16_t* z1024; int rowmask;
    __device__ __forceinline__ void operator()(const f32x4 (&acc)[2][2][4][2], const pg8::Unit& u, int wr, int wc, int fr, int fq) const {
        bf16_t* base; int ld, colt;
        if (u.pn < 6) { base = z512 + (size_t)(u.pn >> 1) * ((size_t)NTOK * 512); ld = 512; colt = (u.pn & 1) * 256; }
        else { const int q = u.pn - 6; base = z1024 + (size_t)(q >> 2) * ((size_t)NTOK * 1024); ld = 1024; colt = (q & 3) * 256; }
        const int row0 = (u.pm * 256 + wr * 64 + fr) & rowmask, col0 = colt + wc * 32 + 8 * fq;
#pragma unroll
        for (int ai = 0; ai < 2; ++ai)
#pragma unroll
            for (int m = 0; m < 4; ++m) { bf16_t* rowp = base + (size_t)(row0 + ai * 128 + m * 16) * ld + col0;
#pragma unroll
                for (int bj = 0; bj < 2; ++bj) { const f32x4 v0 = acc[ai][bj][m][0], v1 = acc[ai][bj][m][1];
                    __builtin_nontemporal_store(((u32x4){pk2(v0[0], v0[1]), pk2(v0[2], v0[3]), pk2(v1[0], v1[1]), pk2(v1[2], v1[3])}), (u32x4*)(rowp + bj * 128)); } }
    }
};
struct EpiB {
    static constexpr bool PERM = true;
    bf16_t* O; int ldc;
    __device__ __forceinline__ void operator()(const f32x4 (&acc)[2][2][4][2], const pg8::Unit& u, int wr, int wc, int fr, int fq) const {
        const int row0 = u.pm * 256 + wr * 64 + fr, col0 = u.pn * 256 + wc * 32 + 8 * fq;
#pragma unroll
        for (int ai = 0; ai < 2; ++ai)
#pragma unroll
            for (int m = 0; m < 4; ++m) { bf16_t* rowp = O + (size_t)(row0 + ai * 128 + m * 16) * ldc + col0;
#pragma unroll
                for (int bj = 0; bj < 2; ++bj) { const f32x4 v0 = acc[ai][bj][m][0], v1 = acc[ai][bj][m][1];
                    __builtin_nontemporal_store(((u32x4){pk2(v0[0], v0[1]), pk2(v0[2], v0[3]), pk2(v1[0], v1[1]), pk2(v1[2], v1[3])}), (u32x4*)(rowp + bj * 128)); } }
    }
};
struct EpiVT {
    static constexpr bool PERM = true;
    bf16_t* O;
    __device__ __forceinline__ void operator()(const f32x4 (&acc)[2][2][4][2], const pg8::Unit& u, int wr, int wc, int fr, int fq) const {
        const int row0 = u.pm * 256 + wr * 64 + fr, col0 = u.pn * 256 + wc * 32 + 8 * fq;
        const unsigned off0 = (unsigned)((((col0 >> 6) * 2048 + row0) * 64 + (col0 & 63)) * 2);
        char* const base = (char*)O;
#pragma unroll
        for (int ai = 0; ai < 2; ++ai)
#pragma unroll
            for (int m = 0; m < 4; ++m) {
#pragma unroll
                for (int bj = 0; bj < 2; ++bj) { const f32x4 v0 = acc[ai][bj][m][0], v1 = acc[ai][bj][m][1];
                    __builtin_nontemporal_store(((u32x4){pk2(v0[0], v0[1]), pk2(v0[2], v0[3]), pk2(v1[0], v1[1]), pk2(v1[2], v1[3])}), (u32x4*)(base + (off0 + (unsigned)((ai * 128 + m * 16) * 128 + bj * 524288)))); }
                asm volatile("" ::: "memory"); }
    }
};
struct EpiX1 {
    static constexpr bool PERM = false;
    const float* x; float* out; unsigned char* xb;
    __device__ __forceinline__ void operator()(const f32x4 (&acc)[2][2][4][2], const pg8::Unit& u, int wr, int wc, int fr, int fq) const {
        const int row0 = u.pm * 256 + wr * 64 + fr, col0 = u.pn * 256 + wc * 32 + 4 * fq;
#pragma unroll
        for (int ai = 0; ai < 2; ++ai) {
            f32x4 xv[4][2][2];
#pragma unroll
            for (int m = 0; m < 4; ++m)
#pragma unroll
                for (int bj = 0; bj < 2; ++bj)
#pragma unroll
                    for (int n = 0; n < 2; ++n) xv[m][bj][n] = __builtin_nontemporal_load((const f32x4*)(x + (size_t)(row0 + ai * 128 + m * 16) * D + col0 + bj * 128 + n * 16));
#pragma unroll
            for (int m = 0; m < 4; ++m) { const size_t ro = (size_t)(row0 + ai * 128 + m * 16) * D + col0;
#pragma unroll
                for (int bj = 0; bj < 2; ++bj)
#pragma unroll
                    for (int n = 0; n < 2; ++n) { const size_t o = ro + bj * 128 + n * 16; const f32x4 v = xv[m][bj][n] + acc[ai][bj][m][n];
                        *(f32x4*)(out + o) = v; *(unsigned*)(xb + o) = pk4_fp8(v[0], v[1], v[2], v[3]); } }
            asm volatile("" ::: "memory"); }
    }
};
struct EpiSwiglu {
    static constexpr bool PERM = true;
    const float* rstd_slot; const float* b1p; unsigned char* act;
    __device__ __forceinline__ void operator()(const f32x4 (&acc)[2][2][4][2], const pg8::Unit& u, int wr, int wc, int fr, int fq) const {
        const int e = u.pn >> 3, pnl = u.pn & 7; const int row0 = u.pm * 256 + wr * 64 + fr, j0 = wc * 32 + 8 * fq;
        const float* bb = b1p + e * 2048 + pnl * 256 + j0;
        const f32x4 bg0 = *(const f32x4*)(bb), bg1 = *(const f32x4*)(bb + 4), bl0 = *(const f32x4*)(bb + 128), bl1 = *(const f32x4*)(bb + 132);
        float rsv[2][4];
#pragma unroll
        for (int ai = 0; ai < 2; ++ai)
#pragma unroll
            for (int m = 0; m < 4; ++m) rsv[ai][m] = rstd_slot[row0 + ai * 128 + m * 16] * (1.0f / WSCALE);
#pragma unroll
        for (int ai = 0; ai < 2; ++ai)
#pragma unroll
            for (int m = 0; m < 4; ++m) { const int row = row0 + ai * 128 + m * 16; const float rs = rsv[ai][m];
                unsigned w[2];
#pragma unroll
                for (int n = 0; n < 2; ++n) { const f32x4 g4 = acc[ai][0][m][n] * rs + (n ? bg1 : bg0), l4 = acc[ai][1][m][n] * rs + (n ? bl1 : bl0); float r[4];
#pragma unroll
                    for (int i = 0; i < 4; ++i) { const float xg = fminf(g4[i], 7.0f), xl = __builtin_amdgcn_fmed3f(l4[i], -7.0f, 7.0f);
                        const float den = 1.0f + fast_exp2(xg * (-1.702f * LOG2E));
                        r[i] = xg * (xl * ASCALE + ASCALE) * fast_rcp(den); }
                    w[n] = pk4_fp8(r[0], r[1], r[2], r[3]); }
                *(u32x2*)(act + (size_t)row * D + pnl * 128 + j0) = (u32x2){w[0], w[1]};        }
    }
};
struct EpiY {
    static constexpr bool PERM = true;
    const float* gate_slot; const float* b2; unsigned char* ys;
    __device__ __forceinline__ void operator()(const f32x4 (&acc)[2][2][4][2], const pg8::Unit& u, int wr, int wc, int fr, int fq) const {
        const int e = u.pn >> 2, pnl = u.pn & 3; const int row0 = u.pm * 256 + wr * 64 + fr, col0 = pnl * 256 + wc * 32 + 8 * fq;
        f32x4 bv[2][2];
#pragma unroll
        for (int bj = 0; bj < 2; ++bj)
#pragma unroll
            for (int n = 0; n < 2; ++n) bv[bj][n] = *(const f32x4*)(b2 + e * D + col0 + bj * 128 + 4 * n);
        float gtv[2][4];
#pragma unroll
        for (int ai = 0; ai < 2; ++ai)
#pragma unroll
            for (int m = 0; m < 4; ++m) gtv[ai][m] = gate_slot[row0 + ai * 128 + m * 16];
#pragma unroll
        for (int ai = 0; ai < 2; ++ai)
#pragma unroll
            for (int m = 0; m < 4; ++m) { const int row = row0 + ai * 128 + m * 16; const float gt = gtv[ai][m] * YSCALE; unsigned char* rowp = ys + (size_t)row * D + col0;
#pragma unroll
                for (int bj = 0; bj < 2; ++bj) { const f32x4 v0 = (acc[ai][bj][m][0] * (1.0f / (WSCALE * ASCALE)) + bv[bj][0]) * gt, v1 = (acc[ai][bj][m][1] * (1.0f / (WSCALE * ASCALE)) + bv[bj][1]) * gt;
                    *(u32x2*)(rowp + bj * 128) = (u32x2){pk4_fp8(v0[0], v0[1], v0[2], v0[3]), pk4_fp8(v1[0], v1[1], v1[2], v1[3])}; }     }
    }
};
struct EpiPle {
    static constexpr bool PERM = false;
    bf16_t* xb; const bf16_t* pp; const float* rstd2; float* ssp;
    __device__ __forceinline__ void operator()(const f32x4 (&acc)[2][2][4][2], const pg8::Unit& u, int wr, int wc, int fr, int fq) const {
        const int row0 = u.pm * 256 + wr * 64 + fr, col0 = u.pn * 256 + wc * 32 + 4 * fq;
#pragma unroll
        for (int ai = 0; ai < 2; ++ai) {
            u32x2 xw[4][2][2], pw[4][2][2]; float rsv[4];
#pragma unroll
            for (int m = 0; m < 4; ++m) { rsv[m] = rstd2[row0 + ai * 128 + m * 16];
#pragma unroll
                for (int bj = 0; bj < 2; ++bj)
#pragma unroll
                    for (int n = 0; n < 2; ++n) { const size_t o = (size_t)(row0 + ai * 128 + m * 16) * D + col0 + bj * 128 + n * 16; xw[m][bj][n] = *(const u32x2*)(xb + o); pw[m][bj][n] = __builtin_nontemporal_load((const u32x2*)(pp + o)); } }
#pragma unroll
            for (int m = 0; m < 4; ++m) { const int row = row0 + ai * 128 + m * 16; const size_t ro = (size_t)row * D + col0; const float rs = rsv[m] * (1.0f / WSCALE); float ss = 0.f;
#pragma unroll
                for (int bj = 0; bj < 2; ++bj)
#pragma unroll
                    for (int n = 0; n < 2; ++n) { const size_t o = ro + bj * 128 + n * 16; const u32x2 xq = xw[m][bj][n], pq = pw[m][bj][n];
                        const f32x4 a4 = acc[ai][bj][m][n] * rs; f32x4 v;
                        v[0] = bf_lo(xq.x) + sigmoidf_(a4[0]) * bf_lo(pq.x); v[1] = bf_hi(xq.x) + sigmoidf_(a4[1]) * bf_hi(pq.x); v[2] = bf_lo(xq.y) + sigmoidf_(a4[2]) * bf_lo(pq.y); v[3] = bf_hi(xq.y) + sigmoidf_(a4[3]) * bf_hi(pq.y);
                        ss += (v[0] * v[0] + v[1] * v[1]) + (v[2] * v[2] + v[3] * v[3]); *(u32x2*)(xb + o) = (u32x2){pk2(v[0], v[1]), pk2(v[2], v[3])}; }
                ss += __shfl_xor(ss, 16); ss += __shfl_xor(ss, 32);
                if (fq == 0) ssp[(size_t)(u.pn * 4 + wc) * NTOK + row] = ss; }
            asm volatile("" ::: "memory"); }
    }
};
__device__ __forceinline__ float logsigmoid_(float x) { return fminf(x, 0.f) - 0.6931471805599453f * __builtin_amdgcn_logf(1.0f + fast_exp2(-LOG2E * fabsf(x))); }
__device__ __forceinline__ void gla_pre(LAS unsigned char* lds, bf16_t* QG, const bf16_t* KG, const bf16_t* UG, const bf16_t* VGT, const float* __restrict__ b_gk,
                                        bf16_t* KTT, float* DL, bf16_t* OG, int G, int bid, int tid) {
    const int lane = tid & 63, wid = __builtin_amdgcn_readfirstlane(tid >> 6), l15 = lane & 15, lq = lane >> 4;
    constexpr int QS_OFF = 0, KM_OFF = 16640, KP_OFF = 33280, AM_OFF = 51712, SEG_OFF = 60928;
    LAS unsigned char* QS = lds + QS_OFF; LAS unsigned char* KM = lds + KM_OFF; LAS unsigned char* KP = lds + KP_OFF; LAS unsigned char* AM = lds + AM_OFF; LAS float* SEGT = (LAS float*)(lds + SEG_OFF);
    const int dp = lane, seg = wid;
#define GP_BAR() do { asm volatile("s_waitcnt lgkmcnt(0)" ::: "memory"); __builtin_amdgcn_s_barrier(); asm volatile("" ::: "memory"); } while (0)
#define GP_LOAD_QKU(uu) do { const int b_ = (uu) >> 8, c_ = ((uu) >> 2) & 63, hg_ = (uu) & 3; \
        _Pragma("unroll") for (int i = 0; i < 8; ++i) { const size_t off = (size_t)(b_ * TSEQ + c_ * 64 + 8 * seg + i) * 512 + hg_ * 128 + 2 * dp; \
            uwv[i] = __builtin_nontemporal_load((const unsigned*)(UG + off)); qw[i] = __builtin_nontemporal_load((const unsigned*)(QG + off)); kw[i] = __builtin_nontemporal_load((const unsigned*)(KG + off)); } } while (0)
#define GP_LOAD_V(uu) do { const int b_ = (uu) >> 8, c_ = ((uu) >> 2) & 63, hg_ = (uu) & 3; \
        _Pragma("unroll") for (int dvt = 0; dvt < 2; ++dvt) _Pragma("unroll") for (int kk = 0; kk < 2; ++kk) \
            vfr[dvt][kk] = *(const bf16x8*)(VGT + ((size_t)(b_ * NCH + c_) * 2048 + hg_ * 256 + 32 * wid + 16 * dvt + l15) * 64 + 32 * kk + 8 * lq); } while (0)
    unsigned uwv[8], qw[8], kw[8]; bf16x8 vfr[2][2];
    if (bid < NB * NCH * 4) { GP_LOAD_QKU(bid); GP_LOAD_V(bid); }
    for (int u = bid; u < NB * NCH * 4; u += G) {
        const int b = u >> 8, c = (u >> 2) & 63, hg = u & 3;
        const int tok0 = b * TSEQ + c * 64;
        const int un = u + G; const bool hasn = un < NB * NCH * 4;
        const float bias0 = b_gk[hg * 128 + 2 * dp], bias1 = b_gk[hg * 128 + 2 * dp + 1];
        float cum0[8], cum1[8]; float run0 = 0.f, run1 = 0.f;
#pragma unroll
        for (int i = 0; i < 8; ++i) { const unsigned uw = uwv[i];
            run0 += logsigmoid_(bf_lo(uw) + bias0) * 0.0625f; run1 += logsigmoid_(bf_hi(uw) + bias1) * 0.0625f; cum0[i] = run0; cum1[i] = run1; }
        *(LAS f32x2*)(SEGT + seg * 128 + 2 * dp) = (f32x2){run0, run1};
        GP_BAR();
        float off0 = 0.f, off1 = 0.f, tot0 = 0.f, tot1 = 0.f;
#pragma unroll
        for (int s = 0; s < 8; ++s) { const f32x2 v = *(const LAS f32x2*)(SEGT + s * 128 + 2 * dp); if (s < seg) { off0 += v.x; off1 += v.y; } tot0 += v.x; tot1 += v.y; }
        unsigned kpa[4], kpb[4]; float kp0p = 0.f, kp1p = 0.f;
#pragma unroll
        for (int i = 0; i < 8; ++i) { const float b0 = (cum0[i] + off0) * LOG2E, b1 = (cum1[i] + off1) * LOG2E;
            const float e0 = fast_exp2(b0), e1 = fast_exp2(b1), em0 = fast_exp2(-b0), em1 = fast_exp2(-b1), ep0 = fast_exp2(tot0 * LOG2E - b0), ep1 = fast_exp2(tot1 * LOG2E - b1);
            const float q0 = bf_lo(qw[i]), q1 = bf_hi(qw[i]), k0 = bf_lo(kw[i]), k1 = bf_hi(kw[i]);
            const unsigned qt = pk2(q0 * e0, q1 * e1), km = pk2(k0 * em0, k1 * em1);
            const int t = 8 * seg + i; const size_t off = (size_t)(tok0 + t) * 512 + hg * 128 + 2 * dp;
            *(unsigned*)(QG + off) = qt;
            const int la = (dp >> 2) * 1040 + t * 16 + (dp & 3) * 4;
            *(LAS unsigned*)(QS + la) = qt; *(LAS unsigned*)(KM + la) = km;
            const float kp0 = k0 * ep0, kp1 = k1 * ep1;
            if (i & 1) { kpa[i >> 1] = pk2(kp0p, kp0); kpb[i >> 1] = pk2(kp1p, kp1); } else { kp0p = kp0; kp1p = kp1; } }
        *(LAS u32x4*)(KP + (2 * dp) * 144 + 16 * seg) = (u32x4){kpa[0], kpa[1], kpa[2], kpa[3]};
        *(LAS u32x4*)(KP + (2 * dp + 1) * 144 + 16 * seg) = (u32x4){kpb[0], kpb[1], kpb[2], kpb[3]};
        if (seg == 0) *(f32x2*)(DL + (size_t)u * 128 + 2 * dp) = (f32x2){fast_exp2(tot0 * LOG2E), fast_exp2(tot1 * LOG2E)};
        if (hasn) GP_LOAD_QKU(un);
        GP_BAR();
#pragma unroll
        for (int j = 0; j < 2; ++j) { const int ch = tid + 512 * j, dk = ch >> 3, part = ch & 7; *(u32x4*)(KTT + (size_t)u * 8192 + ch * 8) = *(const LAS u32x4*)(KP + dk * 144 + part * 16); }
        { const int st = wid >> 1, ttb = 2 * (wid & 1); f32x4 d1[2] = {(f32x4){0.f, 0.f, 0.f, 0.f}, (f32x4){0.f, 0.f, 0.f, 0.f}};
#pragma unroll
          for (int kk = 0; kk < 4; ++kk) { const int chunk = 4 * kk + lq; const bf16x8 af = *(const LAS bf16x8*)(KM + chunk * 1040 + (16 * st + l15) * 16);
#pragma unroll
              for (int x = 0; x < 2; ++x) { const bf16x8 bfr = *(const LAS bf16x8*)(QS + chunk * 1040 + (16 * (ttb + x) + l15) * 16); d1[x] = MFMA16(af, bfr, d1[x]); } }
#pragma unroll
          for (int x = 0; x < 2; ++x) { const int t = 16 * (ttb + x) + l15, s0 = 16 * st + 4 * lq; float v[4];
#pragma unroll
              for (int i = 0; i < 4; ++i) v[i] = (t >= s0 + i) ? d1[x][i] : 0.f;
              *(LAS u32x2*)(AM + t * 144 + s0 * 2) = (u32x2){pk2(v[0], v[1]), pk2(v[2], v[3])}; } }
        GP_BAR();
        { f32x4 o[2][4];
#pragma unroll
          for (int dvt = 0; dvt < 2; ++dvt)
#pragma unroll
              for (int tt = 0; tt < 4; ++tt) o[dvt][tt] = (f32x4){0.f, 0.f, 0.f, 0.f};
#pragma unroll
          for (int tt = 0; tt < 4; ++tt)
#pragma unroll
              for (int kk = 0; kk < 2; ++kk) { const bf16x8 bfr = *(const LAS bf16x8*)(AM + (16 * tt + l15) * 144 + (32 * kk + 8 * lq) * 2);
#pragma unroll
                  for (int dvt = 0; dvt < 2; ++dvt) o[dvt][tt] = MFMA16(vfr[dvt][kk], bfr, o[dvt][tt]); }
          if (hasn) GP_LOAD_V(un);
#pragma unroll
          for (int dvt = 0; dvt < 2; ++dvt)
#pragma unroll
              for (int tt = 0; tt < 4; ++tt) { const f32x4 v = o[dvt][tt];
                  *(u32x2*)(OG + (size_t)(tok0 + 16 * tt + l15) * D + hg * 256 + 32 * wid + 16 * dvt + 4 * lq) = (u32x2){pk2(v[0], v[1]), pk2(v[2], v[3])}; } }
        GP_BAR();
    }
    asm volatile("s_waitcnt vmcnt(0)" ::: "memory");
#undef GP_BAR
#undef GP_LOAD_QKU
#undef GP_LOAD_V
}

__device__ __forceinline__ void gla_scan(LAS unsigned char* lds, const bf16_t* QT, const bf16_t* KTT, const bf16_t* VGT, const float* DL, bf16_t* OG, float* OGSS, int G, int bid, int tid, int variant) {
    const int lane = tid & 63, wid = __builtin_amdgcn_readfirstlane(tid >> 6), l15 = lane & 15, lq = lane >> 4;
    const int dvt = wid & 1, tt = wid >> 1;
    constexpr int STG = 40960, ST_OFF = 122880, STB = 32 * 272;
    int qoff[4], koff[2], voff[2][2];
#pragma unroll
    for (int kk = 0; kk < 4; ++kk) qoff[kk] = (16 * tt + l15) * 256 + (((4 * kk + lq) ^ l15) << 4);
#pragma unroll
    for (int kk = 0; kk < 2; ++kk) { const int dk = 16 * wid + l15; koff[kk] = 16384 + dk * 128 + (((4 * kk + lq) ^ ((dk >> 1) & 7)) << 4);
#pragma unroll
        for (int nt = 0; nt < 2; ++nt) { const int dv = 16 * nt + l15; voff[nt][kk] = 32768 + dv * 128 + (((4 * kk + lq) ^ ((dv >> 1) & 7)) << 4); } }
    const int ooff = 36864 + (16 * tt + l15) * 64 + 32 * dvt + 8 * lq;
    for (int u = bid; u < NB * 4 * 8; u += G) {
        const int b = u >> 5, hg = (u >> 3) & 3, sl = u & 7;
        f32x4 S[2] = {(f32x4){0.f, 0.f, 0.f, 0.f}, (f32x4){0.f, 0.f, 0.f, 0.f}};
        for (int i = tid; i < STB / 16; i += 512) *(LAS u32x4*)(lds + ST_OFF + i * 16) = (u32x4){0u, 0u, 0u, 0u};
        bf16_t* op = OG + (size_t)(b * TSEQ + 16 * tt + l15) * D + hg * 256 + sl * 32 + 16 * dvt + 4 * lq;
        const float* dp = DL + (size_t)(b * 256 + hg) * 128 + 16 * wid + 4 * lq;
        float* ssp = OGSS + ((size_t)(b * TSEQ + 16 * tt + l15) * 4 + hg) * 16 + sl * 2 + dvt;
        const bf16_t* gq[2]; const bf16_t* gk[2]; const bf16_t* gv;
#pragma unroll
        for (int x = 0; x < 2; ++x) { const int j = 2 * wid + x;
            { const int row = 4 * j + (lane >> 4), ch = (lane & 15) ^ (row & 15); gq[x] = QT + (size_t)(b * TSEQ + row) * 512 + hg * 128 + 8 * ch; }
            { const int row = 8 * j + (lane >> 3), ch = (lane & 7) ^ ((row >> 1) & 7); gk[x] = KTT + (size_t)(b * 256 + hg) * 8192 + row * 64 + 8 * ch; } }
        if (wid < 4) { const int row = 8 * wid + (lane >> 3), ch = (lane & 7) ^ ((row >> 1) & 7); gv = VGT + ((size_t)(b * NCH) * 2048 + hg * 256 + sl * 32 + row) * 64 + 8 * ch; }
        else { const int row = 16 * (wid - 4) + (lane >> 2); gv = OG + (size_t)(b * TSEQ + row) * D + hg * 256 + sl * 32 + 8 * (lane & 3); }
        const size_t gvstep = wid < 4 ? (size_t)2048 * 64 : (size_t)64 * D;
#define SCAN_DMA(c, sidx) do { if (!(variant & 2)) { LAS unsigned char* sb_ = lds + (sidx) * STG; \
        _Pragma("unroll") for (int x = 0; x < 2; ++x) { \
            __builtin_amdgcn_global_load_lds((const unsigned*)(gq[x] + (size_t)(c) * 64 * 512), (LAS unsigned*)(sb_ + (2 * wid + x) * 1024), 16, 0, 0); \
            __builtin_amdgcn_global_load_lds((const unsigned*)(gk[x] + (size_t)(c) * 4 * 8192), (LAS unsigned*)(sb_ + 16384 + (2 * wid + x) * 1024), 16, 0, 0); } \
        __builtin_amdgcn_global_load_lds((const unsigned*)(gv + (size_t)(c) * gvstep), (LAS unsigned*)(sb_ + 32768 + wid * 1024), 16, 0, 0); } } while (0)
#define SCAN_STEP(c, sidx, DV, WAITN) do { const LAS unsigned char* sb = lds + (sidx) * STG; \
        const LAS unsigned char* stc = lds + ST_OFF + ((c) & 1) * STB; LAS unsigned char* stn = lds + ST_OFF + (((c) & 1) ^ 1) * STB; \
        f32x4 oT = (f32x4){0.f, 0.f, 0.f, 0.f}; \
        _Pragma("unroll") for (int kk = 0; kk < 4; ++kk) { const bf16x8 sa = *(const LAS bf16x8*)(stc + (16 * dvt + l15) * 272 + (32 * kk + 8 * lq) * 2); const bf16x8 qb = *(const LAS bf16x8*)(sb + qoff[kk]); oT = MFMA16(sa, qb, oT); } \
        f32x4 dS0 = (f32x4){0.f, 0.f, 0.f, 0.f}, dS1 = (f32x4){0.f, 0.f, 0.f, 0.f}; \
        _Pragma("unroll") for (int kk = 0; kk < 2; ++kk) { const bf16x8 ka = *(const LAS bf16x8*)(sb + koff[kk]); dS0 = MFMA16(ka, *(const LAS bf16x8*)(sb + voff[0][kk]), dS0); dS1 = MFMA16(ka, *(const LAS bf16x8*)(sb + voff[1][kk]), dS1); } \
        const u32x2 oi = *(const LAS u32x2*)(sb + ooff); \
        S[0] = S[0] * DV + dS0; S[1] = S[1] * DV + dS1; \
        *(LAS u32x2*)(stn + (l15) * 272 + (16 * wid + 4 * lq) * 2) = (u32x2){pk2(S[0][0], S[0][1]), pk2(S[0][2], S[0][3])}; \
        *(LAS u32x2*)(stn + (16 + l15) * 272 + (16 * wid + 4 * lq) * 2) = (u32x2){pk2(S[1][0], S[1][1]), pk2(S[1][2], S[1][3])}; \
        const float o0 = oT[0] + bf_lo(oi.x), o1 = oT[1] + bf_hi(oi.x), o2 = oT[2] + bf_lo(oi.y), o3 = oT[3] + bf_hi(oi.y); \
        if (!(variant & 4)) *(u32x2*)(op + (size_t)(c) * 64 * D) = (u32x2){pk2(o0, o1), pk2(o2, o3)}; \
        float ss = (o0 * o0 + o1 * o1) + (o2 * o2 + o3 * o3); ss += __shfl_xor(ss, 16); ss += __shfl_xor(ss, 32); \
        if (lane < 16 && !(variant & 4)) ssp[(size_t)(c) * 64 * 64] = ss; \
        asm volatile("s_waitcnt vmcnt(" #WAITN ") lgkmcnt(0)" ::: "memory"); __builtin_amdgcn_s_barrier(); asm volatile("" ::: "memory"); } while (0)
        f32x4 dA, dB, dC;
        SCAN_DMA(0, 0); dA = *(const f32x4*)(dp); SCAN_DMA(1, 1); dB = *(const f32x4*)(dp + 4 * 128);
        asm volatile("s_waitcnt vmcnt(0) lgkmcnt(0)" ::: "memory"); __builtin_amdgcn_s_barrier(); asm volatile("" ::: "memory");
        for (int c = 0; c < 60; c += 3) {
            SCAN_DMA(c + 2, 2); dC = *(const f32x4*)(dp + (size_t)(c + 2) * 4 * 128); SCAN_STEP(c, 0, dA, 8);
            SCAN_DMA(c + 3, 0); dA = *(const f32x4*)(dp + (size_t)(c + 3) * 4 * 128); SCAN_STEP(c + 1, 1, dB, 8);
            SCAN_DMA(c + 4, 1); dB = *(const f32x4*)(dp + (size_t)(c + 4) * 4 * 128); SCAN_STEP(c + 2, 2, dC, 8);
        }
        SCAN_DMA(62, 2); dC = *(const f32x4*)(dp + (size_t)62 * 4 * 128); SCAN_STEP(60, 0, dA, 0);
        SCAN_DMA(63, 0); dA = *(const f32x4*)(dp + (size_t)63 * 4 * 128); SCAN_STEP(61, 1, dB, 0);
        SCAN_STEP(62, 2, dC, 0);
        SCAN_STEP(63, 0, dA, 0);
#undef SCAN_DMA
#undef SCAN_STEP
        asm volatile("s_waitcnt vmcnt(0)" ::: "memory"); __syncthreads();
    }
}

__device__ __forceinline__ void attn_softmax_blk(f32x16& p0, f32x16& p1, f32x16& O0, f32x16& O1, float& mrun, float& lsum, bf16x8 (&pf)[4]) {
    const float PINF = __builtin_inff();
    float m0 = __builtin_amdgcn_fmed3f(p0[0], p1[0], PINF), m1 = __builtin_amdgcn_fmed3f(p0[1], p1[1], PINF), m2 = __builtin_amdgcn_fmed3f(p0[2], p1[2], PINF), m3 = __builtin_amdgcn_fmed3f(p0[3], p1[3], PINF);
#pragma unroll
    for (int r = 4; r < 16; r += 4) {
        m0 = __builtin_amdgcn_fmed3f(m0, p0[r], PINF); m1 = __builtin_amdgcn_fmed3f(m1, p0[r + 1], PINF); m2 = __builtin_amdgcn_fmed3f(m2, p0[r + 2], PINF); m3 = __builtin_amdgcn_fmed3f(m3, p0[r + 3], PINF);
        m0 = __builtin_amdgcn_fmed3f(m0, p1[r], PINF); m1 = __builtin_amdgcn_fmed3f(m1, p1[r + 1], PINF); m2 = __builtin_amdgcn_fmed3f(m2, p1[r + 2], PINF); m3 = __builtin_amdgcn_fmed3f(m3, p1[r + 3], PINF); }
    float mx = __builtin_amdgcn_fmed3f(__builtin_amdgcn_fmed3f(m0, m1, PINF), __builtin_amdgcn_fmed3f(m2, m3, PINF), PINF);
    mx = __builtin_amdgcn_fmed3f(mx, __shfl_xor(mx, 32), PINF);
    const float mnew = __builtin_amdgcn_fmed3f(mrun, mx, PINF);
    { const float alpha = fast_exp2(mrun - mnew); lsum *= alpha;
#pragma unroll
        for (int r = 0; r < 16; ++r) { O0[r] *= alpha; O1[r] *= alpha; } }
    mrun = mnew;
    const f32x2 mm = (f32x2){mnew, mnew}; f32x2 ps2 = (f32x2){0.f, 0.f};
#pragma unroll
    for (int r = 0; r < 16; r += 2) {
        f32x2 a = (f32x2){p0[r], p0[r + 1]} - mm, b = (f32x2){p1[r], p1[r + 1]} - mm;
        a.x = fast_exp2(a.x); a.y = fast_exp2(a.y); b.x = fast_exp2(b.x); b.y = fast_exp2(b.y);
        p0[r] = a.x; p0[r + 1] = a.y; p1[r] = b.x; p1[r + 1] = b.y; ps2 += a; ps2 += b; }
    lsum += ps2.x + ps2.y;
    u32x4 w;
    w = (u32x4){pk2(p0[0], p0[1]), pk2(p0[2], p0[3]), pk2(p0[4], p0[5]), pk2(p0[6], p0[7])}; pf[0] = __builtin_bit_cast(bf16x8, w);
    w = (u32x4){pk2(p0[8], p0[9]), pk2(p0[10], p0[11]), pk2(p0[12], p0[13]), pk2(p0[14], p0[15])}; pf[1] = __builtin_bit_cast(bf16x8, w);
    w = (u32x4){pk2(p1[0], p1[1]), pk2(p1[2], p1[3]), pk2(p1[4], p1[5]), pk2(p1[6], p1[7])}; pf[2] = __builtin_bit_cast(bf16x8, w);
    w = (u32x4){pk2(p1[8], p1[9]), pk2(p1[10], p1[11]), pk2(p1[12], p1[13]), pk2(p1[14], p1[15])}; pf[3] = __builtin_bit_cast(bf16x8, w);
}
__device__ __forceinline__ void attn_bias_init(f32x16& p0, f32x16& p1, const LAS float* bt, bool table, float bconst) {
    if (table) {
#pragma unroll
        for (int g = 0; g < 4; ++g) { const f32x4 a = *(const LAS f32x4*)(bt + 8 * g), bq = *(const LAS f32x4*)(bt + 8 * g + 32);
#pragma unroll
            for (int i = 0; i < 4; ++i) { p0[4 * g + i] = a[i]; p1[4 * g + i] = bq[i]; } } }
    else {
#pragma unroll
        for (int r = 0; r < 16; ++r) { p0[r] = bconst; p1[r] = bconst; } }
}
__device__ __forceinline__ void attn_stage_yb(LAS unsigned char* yt, const f32x16& O0, const f32x16& O1, float inv, int row, int hi) {
#pragma unroll
    for (int d0 = 0; d0 < 2; ++d0)
#pragma unroll
        for (int g = 0; g < 4; ++g) { const int col = 32 * d0 + 8 * g + 4 * hi; float v[4];
#pragma unroll
            for (int i = 0; i < 4; ++i) v[i] = (d0 ? O1[4 * g + i] : O0[4 * g + i]) * inv;
            *(LAS u32x2*)(yt + row * 144 + col * 2) = (u32x2){pk2(v[0], v[1]), pk2(v[2], v[3])}; }
}
__device__ __forceinline__ void attn_merge_rows(const LAS unsigned char* yt, const LAS float* rsr, size_t tok0, int h, int lane, const bf16_t* OG, const bf16_t* RG, const bf16_t* GA, const bf16_t* GBt,
                                                const float* __restrict__ gla_norm, bf16_t* H) {
    const int c8 = lane & 7, col = h * 64 + 8 * c8;
    const f32x4 gn0 = *(const f32x4*)(gla_norm + (col & 255)), gn1 = *(const f32x4*)(gla_norm + (col & 255) + 4);
    u32x4 ogv[8], rgv[8], gav[8], gbv[8];
#pragma unroll
    for (int i = 0; i < 8; ++i) { const size_t o = (tok0 + 8 * i + (lane >> 3)) * D + col;
        ogv[i] = __builtin_nontemporal_load((const u32x4*)(OG + o)); rgv[i] = __builtin_nontemporal_load((const u32x4*)(RG + o)); gav[i] = __builtin_nontemporal_load((const u32x4*)(GA + o)); gbv[i] = __builtin_nontemporal_load((const u32x4*)(GBt + o)); }
#pragma unroll
    for (int i = 0; i < 8; ++i) { const int row = 8 * i + (lane >> 3); const size_t o = (tok0 + row) * D + col;
        const u32x4 og = ogv[i], rg = rgv[i], ga = gav[i], gb = gbv[i];
        const u32x4 yb = *(const LAS u32x4*)(yt + row * 144 + c8 * 16); const float rstdg = rsr[row];
        unsigned w[4];
#pragma unroll
        for (int q = 0; q < 4; ++q) { const float g0 = q < 2 ? gn0[2 * q] : gn1[2 * q - 4], g1 = q < 2 ? gn0[2 * q + 1] : gn1[2 * q - 3];
            float hv[2];
#pragma unroll
            for (int e = 0; e < 2; ++e) { const float r = e ? bf_hi(rg[q]) : bf_lo(rg[q]), a = e ? bf_hi(ga[q]) : bf_lo(ga[q]), bb = e ? bf_hi(gb[q]) : bf_lo(gb[q]);
                const float ogx = e ? bf_hi(og[q]) : bf_lo(og[q]), ybx = e ? bf_hi(yb[q]) : bf_lo(yb[q]), gnx = e ? g1 : g0;
                const float ea = 1.0f + fast_exp2(__builtin_amdgcn_fmed3f(-LOG2E * a, -40.f, 40.f)), er = 1.0f + fast_exp2(__builtin_amdgcn_fmed3f(-LOG2E * r, -40.f, 40.f)), eb = 1.0f + fast_exp2(__builtin_amdgcn_fmed3f(-LOG2E * bb, -40.f, 40.f));
                const float ear = ea * er, n1 = ogx * rstdg * gnx * r;
                hv[e] = (n1 * eb + ybx * ear) * fast_rcp(ear * eb); }
            w[q] = pk2(hv[0], hv[1]); }
        *(u32x4*)(H + o) = (u32x4){w[0], w[1], w[2], w[3]}; }
}
__device__ __forceinline__ void attn_phase(LAS unsigned char* lds, const bf16_t* QA, const bf16_t* KA, const bf16_t* VAT, const bf16_t* OG, const bf16_t* RG, const bf16_t* GA, const bf16_t* GBt,
                                           const float* OGSS, const float* __restrict__ gla_norm, const float* __restrict__ rel_bias, bf16_t* H, int G, int vcu, int tid, int variant) {
    const int lane = tid & 63, wid = __builtin_amdgcn_readfirstlane(tid >> 6), r32 = lane & 31, hi = lane >> 5;
    const int hh = wid >> 1, cq = wid & 1;
    LAS float* RTC = (LAS float*)(lds + ATT_BT_OFF);
    const int sw = (r32 >> 1) & 7;
    int rtc_hgp = -1;
    const int kvbase = hh * 8192 + r32 * 128;
    const int bsA = (63 - r32) & 3, bsB = (31 - r32) & 3;
    const int ybA = (hh * 4 + bsA) * 384 + (63 - r32 - bsA) + 4 * hi - 256;
    const int ybB = (hh * 4 + bsB) * 384 + (31 - r32 - bsB) + 4 * hi - 256;
    for (int u = vcu; u < NB * (NCH / 2) * 4; u += G) {
        const int b = u >> 7, c0 = 2 * ((u >> 2) & 31), hgp = u & 3, h = 4 * hgp + hh;
        const int tqA = b * TSEQ + (c0 + cq) * 64 + r32;
        if (hgp != rtc_hgp) {
            float tv[12];
#pragma unroll
            for (int q = 0; q < 12; ++q) { const int i = tid + 512 * q; const int hq = i / 1536, rem = i - hq * 1536, s = rem / 384, y = rem - s * 384; int d = 319 - (y + s); d = d > 256 ? 256 : d; tv[q] = rel_bias[(4 * hgp + hq) * 513 + d + 256]; }
#pragma unroll
            for (int q = 0; q < 12; ++q) RTC[tid + 512 * q] = LOG2E * tv[q];
            rtc_hgp = hgp; }
        const float bconst = LOG2E * rel_bias[h * 513 + 512];
        bf16x8 qfA[4], qfB[4];
#pragma unroll
        for (int d0 = 0; d0 < 4; ++d0) { qfA[d0] = __builtin_nontemporal_load((const bf16x8*)(QA + (size_t)tqA * D + h * 64 + 16 * d0 + 8 * hi)); qfB[d0] = __builtin_nontemporal_load((const bf16x8*)(QA + (size_t)(tqA + 32) * D + h * 64 + 16 * d0 + 8 * hi)); }
        const int smin = c0 >= 8 ? 0 : 8 - c0;
#define ATT_DMA(st, buf) do { const int tokk = b * TSEQ + (c0 - 8 + (st)) * 64; int ls_ = lane; asm volatile("" : "+v"(ls_));     \
        const char* kb_ = (const char*)(KA + (size_t)tokk * D + h * 64); const char* vb_ = (const char*)(VAT + ((size_t)(tokk >> 6) * 2048 + 1024 + h * 64) * 64); \
        _Pragma("unroll") for (int i = 0; i < 4; ++i) { const int row = 8 * (4 * cq + i) + (ls_ >> 3); const int gch = (ls_ & 7) ^ ((row >> 1) & 7); \
            __builtin_amdgcn_global_load_lds((const unsigned*)(kb_ + (unsigned)(row * (D * 2) + gch * 16)), (LAS unsigned*)(lds + (buf) * 65536 + hh * 8192 + (4 * cq + i) * 1024), 16, 0, 0); \
            __builtin_amdgcn_global_load_lds((const unsigned*)(vb_ + (unsigned)(row * 128 + gch * 16)), (LAS unsigned*)(lds + (buf) * 65536 + 32768 + hh * 8192 + (4 * cq + i) * 1024), 16, 0, 0); } } while (0)
        ATT_DMA(smin, smin & 1);
        f32x16 OA0, OA1, OB0, OB1;
#pragma unroll
        for (int r = 0; r < 16; ++r) { OA0[r] = 0.f; OA1[r] = 0.f; OB0[r] = 0.f; OB1[r] = 0.f; }
        float mA = -INFINITY, lA = 0.f, mB = -INFINITY, lB = 0.f;
        asm volatile("s_waitcnt vmcnt(0)" ::: "memory");
        __syncthreads();
        for (int st = smin; st <= 9; ++st) {
            const int buf = st & 1;
            if (st < 9 && !(variant & 2)) ATT_DMA(st + 1, buf ^ 1);
            const int j = st - cq;
            if (j >= 0 && j <= 8 && !(variant & 1)) {
                const LAS unsigned char* tb = lds + buf * 65536 + kvbase;
                int swl = sw; asm volatile("" : "+v"(swl));
#define KADDR(d0) ((((2 * (d0) + hi) ^ swl) << 4))
#define VADDR(cc) (32768 + ((((cc) ^ swl) << 4)) + 8 * hi)
                f32x16 pA0, pA1, pB0, pB1;
                attn_bias_init(pA0, pA1, RTC + ybA + 64 * j, j >= 4, bconst);
                attn_bias_init(pB0, pB1, RTC + ybB + 64 * j, j >= 4, bconst);
#pragma unroll
                for (int d0 = 0; d0 < 4; ++d0) { const bf16x8 k0 = *(const LAS bf16x8*)(tb + KADDR(d0)), k1 = *(const LAS bf16x8*)(tb + KADDR(d0) + 4096);
                    pA0 = MFMA32(k0, qfA[d0], pA0); pA1 = MFMA32(k1, qfA[d0], pA1); }
                __builtin_amdgcn_sched_barrier(0);
                bf16x8 pfA[4], pfB[4];
#pragma unroll
                for (int d0 = 0; d0 < 4; ++d0) { const bf16x8 k0 = *(const LAS bf16x8*)(tb + KADDR(d0)), k1 = *(const LAS bf16x8*)(tb + KADDR(d0) + 4096);
                    pB0 = MFMA32(k0, qfB[d0], pB0); pB1 = MFMA32(k1, qfB[d0], pB1); }
                attn_softmax_blk(pA0, pA1, OA0, OA1, mA, lA, pfA);
#pragma unroll
                for (int q = 0; q < 8; ++q) { __builtin_amdgcn_sched_group_barrier(0x8, 1, 0); __builtin_amdgcn_sched_group_barrier(0x2, 14, 0); __builtin_amdgcn_sched_group_barrier(0x400, 4, 0); }
                __builtin_amdgcn_sched_barrier(0);
#pragma unroll
                for (int s = 0; s < 4; ++s) {
                    const s16x4 a0l = *(const LAS s16x4*)(tb + VADDR(2 * s)), a0h = *(const LAS s16x4*)(tb + VADDR(2 * s + 1));
                    const s16x4 a1l = *(const LAS s16x4*)(tb + VADDR(2 * s) + 4096), a1h = *(const LAS s16x4*)(tb + VADDR(2 * s + 1) + 4096);
                    const bf16x8 a0 = __builtin_shufflevector(a0l, a0h, 0, 1, 2, 3, 4, 5, 6, 7), a1 = __builtin_shufflevector(a1l, a1h, 0, 1, 2, 3, 4, 5, 6, 7);
                    OA0 = MFMA32(a0, pfA[s], OA0); OA1 = MFMA32(a1, pfA[s], OA1); }
                attn_softmax_blk(pB0, pB1, OB0, OB1, mB, lB, pfB);
#pragma unroll
                for (int q = 0; q < 8; ++q) { __builtin_amdgcn_sched_group_barrier(0x8, 1, 0); __builtin_amdgcn_sched_group_barrier(0x2, 14, 0); __builtin_amdgcn_sched_group_barrier(0x400, 4, 0); }
                __builtin_amdgcn_sched_barrier(0);
#pragma unroll
                for (int s = 0; s < 4; ++s) {
                    const s16x4 a0l = *(const LAS s16x4*)(tb + VADDR(2 * s)), a0h = *(const LAS s16x4*)(tb + VADDR(2 * s + 1));
                    const s16x4 a1l = *(const LAS s16x4*)(tb + VADDR(2 * s) + 4096), a1h = *(const LAS s16x4*)(tb + VADDR(2 * s + 1) + 4096);
                    const bf16x8 a0 = __builtin_shufflevector(a0l, a0h, 0, 1, 2, 3, 4, 5, 6, 7), a1 = __builtin_shufflevector(a1l, a1h, 0, 1, 2, 3, 4, 5, 6, 7);
                    OB0 = MFMA32(a0, pfB[s], OB0); OB1 = MFMA32(a1, pfB[s], OB1); }
            }
            asm volatile("s_waitcnt vmcnt(0)" ::: "memory");
            __syncthreads();
        }
#undef ATT_DMA
#undef KADDR
#undef VADDR
        lA += __shfl_xor(lA, 32); lB += __shfl_xor(lB, 32);
        if (!(variant & 4)) {
            int le = lane; asm volatile("" : "+v"(le));
            const int r32e = le & 31, hie = le >> 5;
            LAS unsigned char* yt = lds + wid * 16384; LAS float* rsr = (LAS float*)(yt + 9216);
            const size_t tok0 = (size_t)b * TSEQ + (c0 + cq) * 64;
            { float ss = 0.f; const f32x4* sp = (const f32x4*)(OGSS + ((tok0 + le) * 4 + hgp) * 16);
#pragma unroll
              for (int k = 0; k < 4; ++k) { const f32x4 v = sp[k]; ss += (v.x + v.y) + (v.z + v.w); }
              rsr[le] = 1.0f / sqrtf(ss * (1.0f / 256.0f) + EPS); }
            attn_stage_yb(yt, OA0, OA1, 1.0f / lA, r32e, hie);
            attn_stage_yb(yt, OB0, OB1, 1.0f / lB, 32 + r32e, hie);
            asm volatile("s_waitcnt lgkmcnt(0)" ::: "memory");
            attn_merge_rows(yt, rsr, tok0, h, le, OG, RG, GA, GBt, gla_norm, H);
        }
        asm volatile("s_waitcnt lgkmcnt(0)" ::: "memory"); __builtin_amdgcn_s_barrier(); asm volatile("" ::: "memory");
    }
}
__device__ __forceinline__ void router_phase(LAS unsigned char* lds, const float* x1, const bf16_t* WRH, const bf16_t* WRL, const float* __restrict__ b_router,
                                             int* TOPI, float* TOPW, float* RSTD1, int* CNT, int G, int bid, int tid) {
    const int lane = tid & 63, wid = __builtin_amdgcn_readfirstlane(tid >> 6), l15 = lane & 15, lq = lane >> 4;
    LAS float* LG = (LAS float*)lds;
    LAS float* RS = (LAS float*)(lds + 128 * 33 * 4);
    LAS int* HIST = (LAS int*)(lds + 128 * 33 * 4 + 512);
    constexpr int WPITCH = 2064; LAS unsigned char* WH = lds + 18432; LAS unsigned char* WL = WH + 32 * WPITCH;
    for (int i = tid; i < 32 * 128; i += 512) { const int e = i >> 7, ch = i & 127;
        *(LAS u32x4*)(WH + e * WPITCH + ch * 16) = *(const u32x4*)(WRH + (size_t)e * D + ch * 8); *(LAS u32x4*)(WL + e * WPITCH + ch * 16) = *(const u32x4*)(WRL + (size_t)e * D + ch * 8); }
    __syncthreads();
    for (int tix = bid; tix < NTOK / 128; tix += G) {
        if (tid < 32) HIST[tid] = 0;
        const int tok = tix * 128 + 16 * wid + l15;
        const float* xr = x1 + (size_t)tok * D + 8 * lq;
        f32x4 acc0 = (f32x4){0.f, 0.f, 0.f, 0.f}, acc1 = (f32x4){0.f, 0.f, 0.f, 0.f}; float ss = 0.f;
#pragma unroll 1
        for (int kb = 0; kb < 32; kb += 8) {
            f32x4 xa[8], xb[8];
#pragma unroll
            for (int q = 0; q < 8; ++q) { xa[q] = *(const f32x4*)(xr + 32 * (kb + q)); xb[q] = *(const f32x4*)(xr + 32 * (kb + q) + 4); }
#pragma unroll
            for (int q = 0; q < 8; ++q) { const int ks = kb + q; const f32x4 a = xa[q], b = xb[q];
                ss += (a.x * a.x + a.y * a.y) + (a.z * a.z + a.w * a.w) + (b.x * b.x + b.y * b.y) + (b.z * b.z + b.w * b.w);
                const unsigned h0 = pk2(a.x, a.y), h1 = pk2(a.z, a.w), h2 = pk2(b.x, b.y), h3 = pk2(b.z, b.w);
                const unsigned l0 = pk2(a.x - bf_lo(h0), a.y - bf_hi(h0)), l1 = pk2(a.z - bf_lo(h1), a.w - bf_hi(h1)), l2 = pk2(b.x - bf_lo(h2), b.y - bf_hi(h2)), l3 = pk2(b.z - bf_lo(h3), b.w - bf_hi(h3));
                const bf16x8 ahi = __builtin_bit_cast(bf16x8, ((u32x4){h0, h1, h2, h3})), alo = __builtin_bit_cast(bf16x8, ((u32x4){l0, l1, l2, l3}));
                const int wo = (32 * ks + 8 * lq) * 2;
                const bf16x8 bh0 = *(const LAS bf16x8*)(WH + l15 * WPITCH + wo), bh1 = *(const LAS bf16x8*)(WH + (16 + l15) * WPITCH + wo);
                const bf16x8 bl0 = *(const LAS bf16x8*)(WL + l15 * WPITCH + wo), bl1 = *(const LAS bf16x8*)(WL + (16 + l15) * WPITCH + wo);
                acc0 = MFMA16(ahi, bh0, acc0); acc0 = MFMA16(alo, bh0, acc0); acc0 = MFMA16(ahi, bl0, acc0);
                acc1 = MFMA16(ahi, bh1, acc1); acc1 = MFMA16(alo, bh1, acc1); acc1 = MFMA16(ahi, bl1, acc1); }
        }
        ss += __shfl_xor(ss, 16); ss += __shfl_xor(ss, 32);
        const float rstd = 1.0f / sqrtf(ss * (1.f / D) + EPS);
        if (lq == 0) { RS[16 * wid + l15] = rstd; RSTD1[tok] = rstd; }
        __syncthreads();
#pragma unroll
        for (int i = 0; i < 4; ++i) { const int tl = 16 * wid + 4 * lq + i; const float r = RS[tl];
            LG[tl * 33 + l15] = acc0[i] * r + b_router[l15]; LG[tl * 33 + 16 + l15] = acc1[i] * r + b_router[16 + l15]; }
        __syncthreads();
        if (tid < 128) {
            const LAS float* lg = LG + tid * 33; float v[4]; int id[4];
#pragma unroll
            for (int k = 0; k < 4; ++k) { float bv = -INFINITY; int bi = 0;
                for (int e = 0; e < NEXP; ++e) { const float x = lg[e]; bool taken = false;
#pragma unroll
                    for (int q = 0; q < 4; ++q) if (q < k && id[q] == e) taken = true;
                    if (!taken && x > bv) { bv = x; bi = e; } }
                v[k] = bv; id[k] = bi; }
            const float e1 = __expf(v[1] - v[0]), e2 = __expf(v[2] - v[0]), e3 = __expf(v[3] - v[0]); const float inv = 1.0f / (1.0f + e1 + e2 + e3);
            const int t = tix * 128 + tid;
            *(int4*)(TOPI + (size_t)t * 4) = make_int4(id[0], id[1], id[2], id[3]);
            *(f32x4*)(TOPW + (size_t)t * 4) = (f32x4){inv, e1 * inv, e2 * inv, e3 * inv};
#pragma unroll
            for (int k = 0; k < 4; ++k) __hip_atomic_fetch_add(&HIST[id[k]], 1, __ATOMIC_RELAXED, __HIP_MEMORY_SCOPE_WORKGROUP);
        }
        __syncthreads();
        if (tid < 32) CNT[tix * 32 + tid] = HIST[tid];
        __syncthreads();
    }
}

__device__ __forceinline__ void assign_phase(LAS unsigned char* lds, const int* TOPI, const float* TOPW, const float* RSTD1, const int* CNT,
                                             int* TOKSLOT, float* GATESLOT, float* RSTDSLOT, int* SLOTTOK, int* TILEEXP, int* NTILES, int G, int bid, int tid) {
    LAS int* PART = (LAS int*)lds;
    LAS int* PARTB = PART + 512;
    LAS int* TOT = PART + 1024;
    LAS int* BEF = PART + 1056;
    LAS int* BASE = PART + 1088;
    LAS int* IDS = PART + 1120;
    LAS int* WC = PART + 1632;
    constexpr int NTILE = NTOK / 128;
    for (int tix = bid; tix < NTILE; tix += G) {
        { const int e = tid & 31, part = tid >> 5; int s = 0, sb = 0;
          int cv[16];
#pragma unroll
          for (int q = 0; q < 16; ++q) cv[q] = CNT[(part * 16 + q) * 32 + e];
#pragma unroll
          for (int q = 0; q < 16; ++q) { s += cv[q]; if (part * 16 + q < tix) sb += cv[q]; }
          PART[part * 32 + e] = s; PARTB[part * 32 + e] = sb; }
        IDS[tid] = TOPI[(size_t)tix * 512 + tid];
        __syncthreads();
        if (tid < 32) { int s = 0, sb = 0;
            for (int p = 0; p < 16; ++p) { s += PART[p * 32 + tid]; sb += PARTB[p * 32 + tid]; }
            TOT[tid] = s; BEF[tid] = sb; }
        __syncthreads();
        if (tid < 32) { int base = 0; for (int e = 0; e < tid; ++e) base += (TOT[e] + 255) & ~255; BASE[tid] = base; }
        __syncthreads();
        {
            const int lane = tid & 63, w = tid >> 6; const int id = IDS[tid]; int rank = 0, cnt = 0;
            for (int e = 0; e < NEXP; ++e) { const unsigned long long mask = __ballot(id == e); if (lane == e) cnt = __popcll(mask); if (id == e) rank = __popcll(mask & ((1ull << lane) - 1ull)); }
            if (lane < 32) WC[w * 32 + lane] = cnt;
            __syncthreads();
            int pre = 0;
            for (int q = 0; q < 8; ++q) if (q < w) pre += WC[q * 32 + id];
            const int slot = BASE[id] + BEF[id] + pre + rank; const int t = tix * 128 + (tid >> 2);
            TOKSLOT[slot] = t; GATESLOT[slot] = TOPW[(size_t)tix * 512 + tid]; RSTDSLOT[slot] = RSTD1[t]; SLOTTOK[(size_t)tix * 512 + tid] = slot;
        }
        if (tix == 0) {
            if (tid < 32) { const int e = tid, nt = (TOT[e] + 255) >> 8, tb = BASE[e] >> 8;
                for (int i = 0; i < nt; ++i) TILEEXP[tb + i] = e;
                if (e == 31) NTILES[0] = tb + nt; }
            for (int e = 0; e < NEXP; ++e) { const int s0 = BASE[e] + TOT[e], s1 = BASE[e] + ((TOT[e] + 255) & ~255);
                for (int s = s0 + tid; s < s1; s += 512) { TOKSLOT[s] = 0; GATESLOT[s] = 0.f; RSTDSLOT[s] = 0.f; } }
        }
        __syncthreads();
    }
}

__device__ __forceinline__ void combine_row_load(const float* x1, const unsigned char* YS, const int* SLOTTOK, int m, int lane, f32x4 (&v)[4], unsigned (&yw)[4][4]) {
    const int4 sl = *(const int4*)(SLOTTOK + (size_t)m * 4);
    const f32x4* xr = (const f32x4*)(x1 + (size_t)m * D) + lane;
    const int sls[4] = {sl.x, sl.y, sl.z, sl.w};
#pragma unroll
    for (int j = 0; j < 4; ++j) v[j] = __builtin_nontemporal_load(xr + 64 * j);
#pragma unroll
    for (int k = 0; k < 4; ++k) { const unsigned* yr = (const unsigned*)(YS + (size_t)sls[k] * D) + lane;
#pragma unroll
        for (int j = 0; j < 4; ++j) yw[k][j] = __builtin_nontemporal_load(yr + 64 * j); }
}
__device__ __forceinline__ void combine_row_finish(f32x4 (&v)[4], const unsigned (&yw)[4][4], bf16_t* X2B, unsigned char* XF8, float* RSTD2, int m, int lane) {
#pragma unroll
    for (int k = 0; k < 4; ++k)
#pragma unroll
        for (int j = 0; j < 4; ++j) { const unsigned w = yw[k][j]; f32x2 lo = __builtin_amdgcn_cvt_pk_f32_fp8((int)w, false), hi = __builtin_amdgcn_cvt_pk_f32_fp8((int)w, true);
            v[j].x += lo.x * (1.0f / YSCALE); v[j].y += lo.y * (1.0f / YSCALE); v[j].z += hi.x * (1.0f / YSCALE); v[j].w += hi.y * (1.0f / YSCALE); }
    float s = 0.f;
#pragma unroll
    for (int j = 0; j < 4; ++j) s += (v[j].x * v[j].x + v[j].y * v[j].y) + (v[j].z * v[j].z + v[j].w * v[j].w);
    s = wave_sum(s);
    u32x2* ob = (u32x2*)(X2B + (size_t)m * D) + lane; unsigned* o8 = (unsigned*)(XF8 + (size_t)m * D) + lane;
#pragma unroll
    for (int j = 0; j < 4; ++j) { ob[64 * j] = (u32x2){pk2(v[j].x, v[j].y), pk2(v[j].z, v[j].w)}; o8[64 * j] = pk4_fp8(v[j].x, v[j].y, v[j].z, v[j].w); }
    if (lane == 0) RSTD2[m] = 1.0f / sqrtf(s * (1.f / D) + EPS);
}
__device__ __forceinline__ void combine_phase(const float* x1, const unsigned char* YS, const int* SLOTTOK, bf16_t* X2B, unsigned char* XF8, float* RSTD2, int G, int vcu, int tid) {
    const int lane = tid & 63, wave = tid >> 6; const int gw = vcu * NWAVES + wave, NGW = G * NWAVES;
    for (int m = gw; m < NTOK; m += 2 * NGW) {
        const int m2 = m + NGW; const bool has2 = m2 < NTOK;
        f32x4 va[4], vb[4]; unsigned ya[4][4], yb[4][4];
        combine_row_load(x1, YS, SLOTTOK, m, lane, va, ya);
        combine_row_load(x1, YS, SLOTTOK, has2 ? m2 : m, lane, vb, yb);
        combine_row_finish(va, ya, X2B, XF8, RSTD2, m, lane);
        if (has2) combine_row_finish(vb, yb, X2B, XF8, RSTD2, m2, lane);
    }
}

__device__ __forceinline__ void final_phase(float* out, const bf16_t* X3B, const float* SSP, const float* __restrict__ ln_final, int G, int vcu, int tid) {
    const int lane = tid & 63, wave = tid >> 6; const int gw = vcu * NWAVES + wave, NGW = G * NWAVES;
    f32x4 gn[4];
#pragma unroll
    for (int j = 0; j < 4; ++j) gn[j] = *((const f32x4*)ln_final + lane + 64 * j);
    for (int m = gw; m < NTOK; m += 2 * NGW) {
        const int m2 = (m + NGW < NTOK) ? m + NGW : m;
        float s = (lane < 16) ? SSP[(size_t)lane * NTOK + m] : 0.f, s2 = (lane < 16) ? SSP[(size_t)lane * NTOK + m2] : 0.f;
        const u32x2* xr = (const u32x2*)(X3B + (size_t)m * D) + lane; const u32x2* xr2 = (const u32x2*)(X3B + (size_t)m2 * D) + lane; u32x2 w[4], w2[4];
#pragma unroll
        for (int j = 0; j < 4; ++j) { w[j] = __builtin_nontemporal_load(xr + 64 * j); w2[j] = __builtin_nontemporal_load(xr2 + 64 * j); }
        s = wave_sum(s); s2 = wave_sum(s2);
        const float rstd = 1.0f / sqrtf(s * (1.f / D) + EPS), rstd2 = 1.0f / sqrtf(s2 * (1.f / D) + EPS);
        f32x4* orow = (f32x4*)(out + (size_t)m * D) + lane; f32x4* orow2 = (f32x4*)(out + (size_t)m2 * D) + lane;
#pragma unroll
        for (int j = 0; j < 4; ++j) { const f32x4 v = (f32x4){bf_lo(w[j].x), bf_hi(w[j].x), bf_lo(w[j].y), bf_hi(w[j].y)}; __builtin_nontemporal_store(v * rstd * gn[j], orow + 64 * j); }
        if (m2 != m) {
#pragma unroll
            for (int j = 0; j < 4; ++j) { const f32x4 v = (f32x4){bf_lo(w2[j].x), bf_hi(w2[j].x), bf_lo(w2[j].y), bf_hi(w2[j].y)}; __builtin_nontemporal_store(v * rstd2 * gn[j], orow2 + 64 * j); } }
    }
}
#ifndef PROBE_VARIANT
#define PROBE_VARIANT 0
#endif
#ifndef MK_N_LAUNCHES
#define MK_N_LAUNCHES 1
#endif
constexpr int N_PHASES = 13;
struct Args { const float* in[20]; float* out; unsigned char* ws; int ph_lo, ph_hi, variant, pad; };
static_assert(sizeof(Args) == 20 * 8 + 8 + 8 + 16, "Args has no padding");

__global__ void __launch_bounds__(NWAVES * 64, 2) fwd_kernel(Args args) {
    extern __shared__ __attribute__((aligned(16))) unsigned char lds_raw[];
    LAS unsigned char* lds = (LAS unsigned char*)lds_raw;
    volatile LAS unsigned* MISC = (volatile LAS unsigned*)(lds + MISC_OFF);
    const int tid = threadIdx.x, G = gridDim.x, bid = blockIdx.x;
    const int vcu = (G % 8 == 0) ? (bid % 8) * (G / 8) + bid / 8 : bid;
    unsigned char* ws = args.ws;
    unsigned* ctl = (unsigned*)(ws + WS_CTL);
    for (int u = tid; u < (LDS_BYTES - MISC_OFF) / 4; u += NWAVES * 64) ((LAS unsigned*)(lds + MISC_OFF))[u] = 0u;
    __syncthreads();
#ifdef PROBE_PREFIX
    const int variant = args.variant;
#else
    constexpr int variant = 0;
#endif
    const int lo = args.ph_lo, hi = args.ph_hi;
    XcdBarrier bar; bar.bar = ctl + CW_BAR; bar.x = 0; bar.st = nullptr;
    if (hi - lo > 1) bar = xcd_barrier_post(ctl + CW_BAR, MISC + 8);
#define IN(k) (lo <= (k) && (k) < hi)
#define TIDP() ({ int t_ = tid; asm volatile("" : "+v"(t_)); t_; })
#define SEAM(k) do { if (IN(k) && IN((k) + 1)) xcd_barrier(bar); } while (0)
    const float* x = args.in[0]; float* out = args.out;
    bf16_t* WIN = (bf16_t*)(ws + WS_WIN);
    bf16_t* XN = (bf16_t*)(ws + WS_XN); bf16_t* OG = (bf16_t*)(ws + WS_OG);
    bf16_t* Z512 = (bf16_t*)(ws + WS_Z512); bf16_t* Z1024 = (bf16_t*)(ws + WS_Z1024);
    bf16_t* QG = Z512; bf16_t* KG = Z512 + (size_t)NTOK * 512; bf16_t* UG = Z512 + (size_t)2 * NTOK * 512;
    bf16_t* RG = Z1024; bf16_t* QA = Z1024 + (size_t)NTOK * D; bf16_t* KA = Z1024 + (size_t)2 * NTOK * D; bf16_t* GA = Z1024 + (size_t)3 * NTOK * D; bf16_t* GBt = Z1024 + (size_t)4 * NTOK * D;
    bf16_t* VT = (bf16_t*)(ws + WS_VT);
    bf16_t* KTT = (bf16_t*)(ws + WS_KTT); float* OGSS = (float*)(ws + WS_OGSS); float* DL = (float*)(ws + WS_DL);
    bf16_t* Hm = (bf16_t*)(ws + WS_H); unsigned char* X1B = ws + WS_X1B;     bf16_t* PP = (bf16_t*)(ws + WS_PP);
    unsigned char* ACT = ws + WS_ACT;     unsigned char* YS = ws + WS_YS;     bf16_t* X2B = (bf16_t*)(ws + WS_X2B);
    unsigned char* rt = ws + WS_RT;
    int* TOPI = (int*)(rt + RT_TOPI); float* TOPW = (float*)(rt + RT_TOPW); float* RSTD1 = (float*)(rt + RT_RSTD1); int* CNT = (int*)(rt + RT_CNT);
    int* TOKSLOT = (int*)(rt + RT_TOKSLOT); float* GATESLOT = (float*)(rt + RT_GATESLOT); float* RSTDSLOT = (float*)(rt + RT_RSTDSLOT); int* SLOTTOK = (int*)(rt + RT_SLOTTOK);
    int* TILEEXP = (int*)(rt + RT_TILEEXP); int* NTILES = (int*)(rt + RT_NTILES); float* RSTD2 = (float*)(rt + RT_RSTD2);
    float* SSP = (float*)(ws + WS_SSP);

    if (IN(0)) {
        P0Args a; a.x = x; a.p = args.in[1]; a.ln_mix = args.in[2]; a.w_in = args.in[3]; a.w_gk = args.in[4]; a.w_out = args.in[8]; a.ln_moe = args.in[9]; a.w_router = args.in[10];
        a.w1 = args.in[12]; a.b1 = args.in[13]; a.w2 = args.in[14]; a.ln_ple = args.in[16]; a.w_pg = args.in[17]; a.w_pp = args.in[18]; a.ws = ws;
        p0_prologue(a, lds, TIDP(), G, vcu);
    }
    SEAM(0);
    if (IN(1)) {
        { pg8::Gemm g{XN, WIN, D}; pg8::StaticOrder S; S.init(NTOK, 6656, G, bid); EpiZ E{Z512, Z1024, (variant & 32) ? 255 : -1}; pg8::gemm_phase(lds, g, S, E, variant); }
        { pg8::Gemm g{WIN + (size_t)6656 * D, XN, D}; pg8::StaticOrder S; S.init(2048, NTOK, G, bid); EpiVT E{VT}; pg8::gemm_phase(lds, g, S, E); }
        { pg8::Gemm g{(const bf16_t*)(ws + WS_PB), (const bf16_t*)(ws + WS_WPP), 256}; pg8::StaticOrder S; S.init(NTOK, D, G, bid); EpiB E{PP, D}; pg8::gemm_phase(lds, g, S, E); }
    }
    SEAM(1);
    if (IN(2)) gla_pre(lds, QG, KG, UG, VT, args.in[5], KTT, DL, OG, G, bid, TIDP());
    SEAM(2);
    if (IN(3)) gla_scan(lds, QG, KTT, VT, DL, OG, OGSS, G, vcu, TIDP(), variant);
    SEAM(3);
    if (IN(4)) attn_phase(lds, QA, KA, VT, OG, RG, GA, GBt, OGSS, args.in[6], args.in[7], Hm, G, vcu, TIDP(), variant);
    SEAM(4);
    if (IN(5)) { pg8::Gemm g{Hm, (const bf16_t*)(ws + WS_WOUT), D}; pg8::StaticOrder S; S.init(NTOK, D, G, bid); EpiX1 E{x, out, X1B}; pg8::gemm_phase(lds, g, S, E); }
    SEAM(5);
    if (IN(6)) router_phase(lds, out, (const bf16_t*)(ws + WS_WRH), (const bf16_t*)(ws + WS_WRL), args.in[11], TOPI, TOPW, RSTD1, CNT, G, bid, TIDP());
    SEAM(6);
    if (IN(7)) assign_phase(lds, TOPI, TOPW, RSTD1, CNT, TOKSLOT, GATESLOT, RSTDSLOT, SLOTTOK, TILEEXP, NTILES, G, bid, TIDP());
    SEAM(7);
    if (IN(8)) { const int ntiles = __builtin_amdgcn_readfirstlane(NTILES[0]);
        pg8::Gemm g{(const bf16_t*)X1B, (const bf16_t*)(ws + WS_W1), D / 2}; pg8::MoeOrder<true> S{TILEEXP, TOKSLOT, ntiles, 8, G, bid}; EpiSwiglu E{RSTDSLOT, (const float*)(ws + WS_B1P), ACT}; pg8::gemm_phase<EpiSwiglu, pg8::MoeOrder<true>, true>(lds, g, S, E, variant); }
    SEAM(8);
    if (IN(9)) { const int ntiles = __builtin_amdgcn_readfirstlane(NTILES[0]);
        pg8::Gemm g{(const bf16_t*)ACT, (const bf16_t*)(ws + WS_W2), D / 2}; pg8::MoeOrder<false> S{TILEEXP, TOKSLOT, ntiles, 4, G, bid}; EpiY E{GATESLOT, args.in[15], YS}; pg8::gemm_phase<EpiY, pg8::MoeOrder<false>, true>(lds, g, S, E, variant); }
    SEAM(9);
    if (IN(10)) combine_phase(out, YS, SLOTTOK, X2B, X1B, RSTD2, G, vcu, TIDP());
    SEAM(10);
    if (IN(11)) { pg8::Gemm g{(const bf16_t*)X1B, (const bf16_t*)(ws + WS_WPG), D / 2}; pg8::StaticOrder S; S.init(NTOK, D, G, bid); EpiPle E{X2B, PP, RSTD2, SSP}; pg8::gemm_phase<EpiPle, pg8::StaticOrder, true>(lds, g, S, E); }
    SEAM(11);
    if (IN(12)) final_phase(out, X2B, SSP, args.in[19], G, vcu, TIDP());
#undef IN
#undef SEAM
}

extern "C" void kernel_launch(void* const* d_in, const int* in_sizes, int n_in, void* d_out, int out_size, void* d_ws, size_t ws_size, hipStream_t stream) {
    static int grid = 0;
    if (grid == 0) {
        if (n_in != 20 || out_size != NTOK * D || ws_size < WS_END) { fprintf(stderr, "kernel_launch: unexpected shapes (n_in %d out %d ws %zu)\n", n_in, out_size, ws_size); grid = -1; return; }
        int dev = 0, cus = 0, per_cu = 0;
        if (hipGetDevice(&dev) != hipSuccess || hipDeviceGetAttribute(&cus, hipDeviceAttributeMultiprocessorCount, dev) != hipSuccess) { grid = -1; return; }
        if (hipFuncSetAttribute((const void*)fwd_kernel, hipFuncAttributeMaxDynamicSharedMemorySize, LDS_BYTES) != hipSuccess) { fprintf(stderr, "kernel_launch: hipFuncSetAttribute failed\n"); grid = -1; return; }
        if (hipOccupancyMaxActiveBlocksPerMultiprocessor(&per_cu, (const void*)fwd_kernel, NWAVES * 64, LDS_BYTES) != hipSuccess || per_cu < 1) { fprintf(stderr, "kernel_launch: occupancy query says %d\n", per_cu); }
        (void)hipGetLastError();
        grid = cus;
    }
    if (grid < 0) return;
    (void)hipMemsetAsync((char*)d_ws + WS_CTL, 0, CTL_ZERO_BYTES, stream);
    Args a{};
    for (int i = 0; i < 20; ++i) a.in[i] = (const float*)d_in[i];
    a.out = (float*)d_out; a.ws = (unsigned char*)d_ws;
#ifdef PROBE_PREFIX
    for (int p = 0; p < PROBE_PREFIX; ++p) { a.ph_lo = p; a.ph_hi = p + 1; a.variant = (p == PROBE_PREFIX - 1) ? PROBE_VARIANT : 0; hipLaunchKernelGGL(fwd_kernel, dim3(grid), dim3(NWAVES * 64), LDS_BYTES, stream, a); }
    a.variant = 0;
#endif
#if MK_N_LAUNCHES == 1
    a.ph_lo = 0; a.ph_hi = N_PHASES;
    hipLaunchKernelGGL(fwd_kernel, dim3(grid), dim3(NWAVES * 64), LDS_BYTES, stream, a);
#else
    for (int p = 0; p < N_PHASES; ++p) { a.ph_lo = p; a.ph_hi = p + 1; hipLaunchKernelGGL(fwd_kernel, dim3(grid), dim3(NWAVES * 64), LDS_BYTES, stream, a); }
#endif
}
```

```cpp
#define MK_N_LAUNCHES 1
#include <hip/hip_runtime.h>
#include <cstdio>
#include <cstdint>

#define GAS __attribute__((address_space(1)))
#define LAS __attribute__((address_space(3)))
typedef unsigned short bf16_t;
typedef short bf16x8 __attribute__((ext_vector_type(8)));
typedef short s16x4 __attribute__((ext_vector_type(4)));
typedef float f32x4 __attribute__((ext_vector_type(4)));
typedef float f32x2 __attribute__((ext_vector_type(2)));
typedef float f32x16 __attribute__((ext_vector_type(16)));
typedef unsigned u32x4 __attribute__((ext_vector_type(4)));
typedef unsigned u32x2 __attribute__((ext_vector_type(2)));
typedef __bf16 bf16x2_t __attribute__((ext_vector_type(2)));
typedef int v8i_t __attribute__((ext_vector_type(8)));
__device__ __forceinline__ unsigned pk4_fp8(float a, float b, float c, float d) { int w = __builtin_amdgcn_cvt_pk_fp8_f32(a, b, 0, false); w = __builtin_amdgcn_cvt_pk_fp8_f32(c, d, w, true); return (unsigned)w; }

__device__ __forceinline__ unsigned pk2(float lo, float hi) { f32x2 v = {lo, hi}; bf16x2_t b = __builtin_convertvector(v, bf16x2_t); return __builtin_bit_cast(unsigned, b); }
__device__ __forceinline__ float bf_lo(unsigned w) { return __uint_as_float(w << 16); }
__device__ __forceinline__ float bf_hi(unsigned w) { return __uint_as_float(w & 0xffff0000u); }
__device__ __forceinline__ float fast_exp2(float x) { return __builtin_amdgcn_exp2f(x); }
__device__ __forceinline__ float fast_rcp(float x) { return __builtin_amdgcn_rcpf(x); }
__device__ __forceinline__ float sigmoidf_(float x) { return fast_rcp(1.0f + fast_exp2(-1.4426950408889634f * x)); }

namespace pg8 {
constexpr int BM = 256, BK = 64, HALF = 128, HTB = HALF * BK * 2, STAGE_BYTES = 8 * HTB, NXCD = 8, WGM = 8;
__host__ __device__ __forceinline__ int lds_byte(int r, int c) { const int st = (r >> 4) * 2 + (c >> 5), rr = r & 15, cc = c & 31, ob = rr * 64 + cc * 2; return st * 1024 + (ob ^ (((ob >> 9) & 1) << 5)); }
__host__ __device__ __forceinline__ void stage_rc(int b, int& R, int& C) { const int st = b / 1024, sb = b % 1024, swz = sb ^ (((sb >> 9) & 1) << 5); R = (st >> 1) * 16 + swz / 64; C = (st & 1) * 32 + (swz % 64) / 2; }
__host__ __device__ __forceinline__ int perm32(int rho) { const int n = rho >> 4, i = rho & 15; return 8 * (i >> 2) + 4 * n + (i & 3); }

struct Unit { int pm, pn; };
struct Gemm { const bf16_t* A; const bf16_t* Bt; int K; };

struct StaticOrder {
    int nM, nN, nwg, G, c;
    __device__ __forceinline__ void init(int M, int N, int G_, int c_) { nM = M / BM; nN = N / BM; nwg = nM * nN; G = G_; c = c_; }
    __device__ __forceinline__ bool next(int i, Unit& u) const {
        const long L = (long)i * G + c; if (L >= nwg) return false;
        int wgid = (int)L; { const int q = nwg / NXCD, r = nwg % NXCD, xcd = wgid % NXCD, off = wgid / NXCD; wgid = (xcd < r ? xcd * (q + 1) : r * (q + 1) + (xcd - r) * q) + off; }
        const int nig = WGM * nN, gid = wgid / nig, fm = gid * WGM, gsz = (nM - fm) < WGM ? (nM - fm) : WGM;
        u.pm = fm + ((wgid % nig) % gsz); u.pn = (wgid % nig) / gsz; return true;
    }
    __device__ __forceinline__ unsigned arow(const Unit& u, int r, int K) const { return (unsigned)((u.pm * BM + r) * K) * 2u; }
};
template <bool GATHER> struct MoeOrder {
    const LAS int* tile_expert;
    const int* rowmap; int ntiles, NT, G, c;
    __device__ __forceinline__ bool next(int i, Unit& u) const {
        const int nx = G >> 3, x = c & 7, y = c >> 3, tper = (ntiles + 7) >> 3, mt0 = x * tper;
        const int q = i * nx + y, ml = q / NT, mt = mt0 + ml;
        if (ml >= tper || mt >= ntiles) return false;
        u.pm = mt; u.pn = __builtin_amdgcn_readfirstlane(tile_expert[mt]) * NT + (q - ml * NT); return true;
    }
    __device__ __forceinline__ unsigned arow(const Unit& u, int r, int K) const {
        if (GATHER) return (unsigned)(rowmap[u.pm * BM + r] * K) * 2u;
        return (unsigned)((u.pm * BM + r) * K) * 2u;
    }
};

template <class E, class = void> struct epi_adj { static constexpr bool v = false; };
template <class E> struct epi_adj<E, decltype((void)E::ADJ)> { static constexpr bool v = E::ADJ; };
template <class Epi, class Sched, bool FP8 = false>
__device__ __forceinline__ void gemm_phase(LAS unsigned char* lds, const Gemm g, const Sched& S, const Epi& E, int variant = 0) {
    int tid_ = threadIdx.x; asm volatile("" : "+v"(tid_));
    const int tid = tid_, wid = __builtin_amdgcn_readfirstlane(tid >> 6), lane = tid & 63, wr = wid >> 2, wc = wid & 3, fr = lane & 15, fq = lane >> 4;
    int K_ = (variant & 8) ? (g.K >> 1) : g.K; asm volatile("" : "+s"(K_));
    const int K = K_, nt = K / BK;
    int RA[2], CA[2]; unsigned voffB[2];
#pragma unroll
    for (int i = 0; i < 2; ++i) { int R, C; stage_rc(tid * 16 + i * 8192, R, C); const int Rb = epi_adj<Epi>::v ? ((R >> 5) * 64 + perm32(R & 31)) : Epi::PERM ? ((R & ~31) + perm32(R & 31)) : R;
        RA[i] = R; CA[i] = C * 2; voffB[i] = (unsigned)(Rb * K + C) * 2u; }
    const size_t kstep = (size_t)(BK * 2);
    const size_t hstep = (size_t)HALF * K * 2;
    const size_t hstB = epi_adj<Epi>::v ? (size_t)32 * K * 2 : hstep;
    const size_t tstep = 2 * hstep;
    const unsigned ldsw = (unsigned)wid * 1024u;
    const int aoff = lds_byte(wr * 64 + fr, fq * 8), boff = lds_byte(wc * 32 + fr, fq * 8);
#define PG8_SA(b, h) (((b) * 2 + (h)) * HTB)
#define PG8_SB(b, h) ((4 + (b) * 2 + (h)) * HTB)
#define PG8_STAGE(bufoff, gbase, voff) do { _Pragma("unroll") for (int _i = 0; _i < 2; ++_i) \
        __builtin_amdgcn_global_load_lds((const unsigned*)((const char*)(gbase) + (voff)[_i]), (LAS unsigned*)(lds + (bufoff) + ldsw + _i * 8192), 16, 0, 0); } while (0)
#define PG8_LDA(dst, b, h) do { _Pragma("unroll") for (int m = 0; m < 4; ++m) _Pragma("unroll") for (int k = 0; k < 2; ++k) dst[m][k] = *(const LAS bf16x8*)(lds + PG8_SA(b, h) + aoff + m * 2048 + k * 1024); } while (0)
#define PG8_LDB(dst, b, h) do { _Pragma("unroll") for (int n = 0; n < 2; ++n) _Pragma("unroll") for (int k = 0; k < 2; ++k) dst[n][k] = *(const LAS bf16x8*)(lds + PG8_SB(b, h) + boff + n * 2048 + k * 1024); } while (0)
#define PG8_CAT(a, b) __builtin_bit_cast(v8i_t, __builtin_shufflevector((a), (b), 0, 1, 2, 3, 4, 5, 6, 7, 8, 9, 10, 11, 12, 13, 14, 15))
#define PG8_MMA(ai, bj, At, Bt) do { __builtin_amdgcn_s_setprio(1); \
        if constexpr (FP8) { _Pragma("unroll") for (int m = 0; m < 4; ++m) _Pragma("unroll") for (int n = 0; n < 2; ++n) \
            acc[ai][bj][m][n] = __builtin_amdgcn_mfma_scale_f32_16x16x128_f8f6f4(PG8_CAT(Bt[n][0], Bt[n][1]), PG8_CAT(At[m][0], At[m][1]), acc[ai][bj][m][n], 0, 0, 0, 0, 0, 0);     } \
        else { _Pragma("unroll") for (int m = 0; m < 4; ++m) _Pragma("unroll") for (int n = 0; n < 2; ++n) _Pragma("unroll") for (int k = 0; k < 2; ++k) \
            acc[ai][bj][m][n] = __builtin_amdgcn_mfma_f32_16x16x32_bf16(Bt[n][k], At[m][k], acc[ai][bj][m][n], 0, 0, 0); } \
        __builtin_amdgcn_s_setprio(0); } while (0)
#define PG8_WAIT_V(n) asm volatile("s_waitcnt vmcnt(" #n ")" ::: "memory")
#define PG8_WAIT_L(n) asm volatile("s_waitcnt lgkmcnt(" #n ")" ::: "memory")
#define PG8_BAR __builtin_amdgcn_s_barrier()
#define PG8_SCHED __builtin_amdgcn_sched_barrier(0)
    Unit cur, nxt; int ui = 0;
    if (!S.next(0, cur)) return;
    f32x4 acc[2][2][4][2];
#pragma unroll
    for (int a = 0; a < 2; ++a)
#pragma unroll
        for (int b = 0; b < 2; ++b)
#pragma unroll
            for (int m = 0; m < 4; ++m)
#pragma unroll
                for (int n = 0; n < 2; ++n) acc[a][b][m][n] = (f32x4){0.f, 0.f, 0.f, 0.f};
    bf16x8 At[4][2], B0[2][2], B1[2][2];
    unsigned vA0[2], vA1[2];
#pragma unroll
    for (int i = 0; i < 2; ++i) { vA0[i] = S.arow(cur, RA[i], K) + (unsigned)CA[i]; vA1[i] = S.arow(cur, HALF + RA[i], K) + (unsigned)CA[i]; }
    const char* const Ab = (const char*)g.A;
    const char* cB = (const char*)g.Bt + (size_t)cur.pn * tstep;
    PG8_STAGE(PG8_SB(0, 0), cB, voffB); PG8_STAGE(PG8_SB(0, 1), cB + hstB, voffB); PG8_STAGE(PG8_SA(0, 0), Ab, vA0); PG8_STAGE(PG8_SA(0, 1), Ab, vA1);
    if (wr == 1) PG8_BAR;
    PG8_WAIT_V(2); PG8_BAR;
    PG8_STAGE(PG8_SB(1, 0), cB + kstep, voffB); PG8_STAGE(PG8_SA(1, 0), Ab + kstep, vA0); PG8_STAGE(PG8_SB(1, 1), cB + hstB + kstep, voffB);
    PG8_WAIT_V(6); PG8_BAR;
    for (;;) {
        const bool has_next = S.next(ui + 1, nxt);
        const char* nB = has_next ? (const char*)g.Bt + (size_t)nxt.pn * tstep : cB;
        for (int t = 0; t < nt; t += 2) {
            const bool last = (t == nt - 2);
            const char* a1 = Ab + (size_t)(t + 1) * kstep;
            const char* a2 = last ? Ab : Ab + (size_t)(t + 2) * kstep; const char* b2 = last ? nB : cB + (size_t)(t + 2) * kstep;
            const char* a3 = a2 + kstep; const char* b3 = b2 + kstep;
            PG8_LDB(B0, 0, 0); PG8_LDB(B1, 0, 1); PG8_SCHED; PG8_LDA(At, 0, 0); PG8_STAGE(PG8_SA(1, 1), a1, vA1);
            if (last && has_next) {
#pragma unroll
                for (int i = 0; i < 2; ++i) { vA0[i] = S.arow(nxt, RA[i], K) + (unsigned)CA[i]; vA1[i] = S.arow(nxt, HALF + RA[i], K) + (unsigned)CA[i]; }
            }
            PG8_WAIT_V(8); PG8_WAIT_L(0); PG8_BAR; PG8_MMA(0, 0, At, B0); PG8_MMA(0, 1, At, B1); PG8_BAR; PG8_SCHED;
            PG8_LDA(At, 0, 1); PG8_STAGE(PG8_SB(0, 0), b2, voffB); PG8_STAGE(PG8_SB(0, 1), b2 + hstB, voffB); PG8_STAGE(PG8_SA(0, 0), a2, vA0);
            PG8_WAIT_V(8); PG8_WAIT_L(0); PG8_BAR; PG8_MMA(1, 0, At, B0); PG8_MMA(1, 1, At, B1); PG8_BAR; PG8_SCHED;
            PG8_LDB(B0, 1, 0); PG8_LDB(B1, 1, 1); PG8_SCHED; PG8_LDA(At, 1, 0); PG8_STAGE(PG8_SA(0, 1), a2, vA1);
            PG8_WAIT_V(8); PG8_WAIT_L(0); PG8_BAR; PG8_MMA(0, 0, At, B0); PG8_MMA(0, 1, At, B1); PG8_BAR; PG8_SCHED;
            PG8_LDA(At, 1, 1); PG8_STAGE(PG8_SB(1, 0), b3, voffB); PG8_STAGE(PG8_SB(1, 1), b3 + hstB, voffB); PG8_STAGE(PG8_SA(1, 0), a3, vA0);
            PG8_WAIT_V(8); PG8_WAIT_L(0); PG8_BAR; PG8_MMA(1, 0, At, B0); PG8_MMA(1, 1, At, B1); PG8_BAR; PG8_SCHED;
        }
        if (wr == 0) PG8_BAR;
        if (!(variant & 16)) E(acc, cur, wr, wc, fr, fq);
        if (!has_next) break;
#pragma unroll
        for (int a = 0; a < 2; ++a)
#pragma unroll
            for (int b = 0; b < 2; ++b)
#pragma unroll
                for (int m = 0; m < 4; ++m)
#pragma unroll
                    for (int n = 0; n < 2; ++n) acc[a][b][m][n] = (f32x4){0.f, 0.f, 0.f, 0.f};
        cur = nxt; cB = nB; ++ui;
        if (wr == 1) PG8_BAR;
    }
    PG8_WAIT_V(0);
    PG8_BAR;
#undef PG8_SA
#undef PG8_SB
#undef PG8_STAGE
#undef PG8_LDA
#undef PG8_LDB
#undef PG8_MMA
#undef PG8_CAT
#undef PG8_WAIT_V
#undef PG8_WAIT_L
#undef PG8_BAR
#undef PG8_SCHED
}
}
constexpr int NB = 8, TSEQ = 4096, NTOK = NB * TSEQ, D = 1024, NCH = 64;
constexpr int NEXP = 32, NSLOT = NTOK * 4 + NEXP * 256;
constexpr float EPS = 1e-6f;
constexpr float LOG2E = 1.4426950408889634f;
constexpr int NWAVES = 8;
constexpr float WSCALE = 64.0f, ASCALE = 4.0f, YSCALE = 16.0f, PSCALE = 16.0f;

constexpr size_t MiB = 1u << 20, KiB = 1u << 10;
constexpr size_t WS_CTL = 0, CTL_ZERO_BYTES = 1 * MiB;
constexpr size_t WS_WIN = 2 * MiB;
constexpr size_t WS_WOUT = 19 * MiB, WS_WPG = 21 * MiB, WS_WPP = 23 * MiB;
constexpr size_t WS_WRH = 23 * MiB + 512 * KiB, WS_WRL = WS_WRH + 64 * KiB, WS_B1P = 23 * MiB + 768 * KiB;
constexpr size_t WS_W1 = 24 * MiB, WS_W2 = 152 * MiB;
constexpr size_t WS_XN = 216 * MiB;
constexpr size_t WS_OG = WS_XN;
constexpr size_t WS_X2B = WS_XN;
constexpr size_t WS_PP = 280 * MiB;
constexpr size_t WS_AT = 312 * MiB;
constexpr size_t WS_X1B = 344 * MiB;
constexpr size_t WS_XN8 = 376 * MiB;
constexpr size_t WS_PB = 408 * MiB;
constexpr size_t WS_SSP = WS_PB;
constexpr size_t WS_RT = 424 * MiB;
constexpr size_t WS_Z512 = 432 * MiB;
constexpr size_t WS_GKL = 432 * MiB + 64 * MiB;
constexpr size_t WS_Z1024 = 528 * MiB;
constexpr size_t WS_VT = 848 * MiB;
constexpr size_t WS_KTT = 976 * MiB;
constexpr size_t WS_WIN8 = WS_KTT;
constexpr size_t WS_OGSS = 1008 * MiB;
constexpr size_t WS_DL = 1016 * MiB;
constexpr size_t WS_END = 1018 * MiB;
constexpr size_t WS_H = WS_Z512;
constexpr size_t WS_ACT = 432 * MiB;
constexpr size_t WS_YS = 704 * MiB;
static_assert(WS_ACT + (size_t)NSLOT * 2048 <= WS_YS && WS_YS + (size_t)NSLOT * 2048 <= WS_KTT, "MoE overlays");
constexpr size_t RT_TOPI = 0, RT_TOPW = 512 * KiB, RT_RSTD1 = 1 * MiB, RT_CNT = 1 * MiB + 128 * KiB;
constexpr size_t RT_TOKSLOT = 2 * MiB, RT_GATESLOT = 3 * MiB, RT_RSTDSLOT = 4 * MiB, RT_SLOTTOK = 5 * MiB, RT_TILEEXP = 6 * MiB, RT_NTILES = 6 * MiB + 8 * KiB, RT_RSTD2 = 6 * MiB + 64 * KiB;
constexpr int CW_TMO = 0, CW_CODE = 1, CW_BAR = 4096;

constexpr int RING_BYTES = 131072, ATT_BT_OFF = 131072, MISC_OFF = 131072 + 24576, LDS_BYTES = 131072 + 24576 + 512;

#define RLX_AGENT __ATOMIC_RELAXED, __HIP_MEMORY_SCOPE_AGENT

#define XB_TMO      128
#define XB_XCNT(j)  (256  + 64 * (j))
#define XB_XSUB(j)  (1280 + 64 * (j))
#define XB_XGEN(j)  (2304 + 64 * (j))
#define XB_TOP      3328
#define XB_TOPGEN   3392
#define XCD_BAR_WORDS 3456
#define XB_SPIN_CAP (1u << 18)
__device__ __forceinline__ unsigned xb_ld(unsigned* p)              { return __hip_atomic_load(p, __ATOMIC_RELAXED, __HIP_MEMORY_SCOPE_AGENT); }
__device__ __forceinline__ unsigned xb_add(unsigned* p, unsigned v) { return __hip_atomic_fetch_add(p, v, __ATOMIC_RELAXED, __HIP_MEMORY_SCOPE_AGENT); }
__device__ __forceinline__ unsigned xb_xcc_id() { return (unsigned)__builtin_amdgcn_s_getreg((3 << 11) | 20) & 0xFu; }
#define XB_SPIN(cond, bar) do { unsigned _sp = 0; while (cond) { __builtin_amdgcn_s_sleep(1); \
    if ((++_sp & 255u) == 0u) { if (xb_ld(&(bar)[XB_TMO])) break; if (_sp > XB_SPIN_CAP) { atomicAdd(&(bar)[XB_TMO], 1u); break; } } } } while (0)
struct XcdBarrier { unsigned* bar; unsigned x; volatile LAS unsigned* st; };
__device__ __forceinline__ XcdBarrier xcd_barrier_post(unsigned* bar, volatile LAS unsigned* st) {
    XcdBarrier b; b.bar = bar; b.x = xb_xcc_id(); b.st = st;
    if (threadIdx.x == 0) (void)xb_add(&bar[XB_XCNT(b.x)], 1u);
    return b;
}
__device__ __forceinline__ void xcd_barrier_complete(unsigned* bar, unsigned x, unsigned& nloc, unsigned& nx) {
    const unsigned G = gridDim.x * gridDim.y * gridDim.z;
    unsigned sum, cnt, mine, sp = 0u;
    for (;;) {
        sum = 0u; cnt = 0u; mine = 0u;
#pragma unroll
        for (unsigned j = 0; j < 16; ++j) { const unsigned c = xb_ld(&bar[XB_XCNT(j)]); sum += c; cnt += (c > 0u) ? 1u : 0u; mine = (j == x) ? c : mine; }
        if (sum == G) break;
        __builtin_amdgcn_s_sleep(1);
        if ((++sp & 255u) == 0u) { if (xb_ld(&bar[XB_TMO])) break; if (sp > XB_SPIN_CAP) { atomicAdd(&bar[XB_TMO], 1u); break; } }
    }
    nloc = mine > 0u ? mine : 1u; nx = cnt > 0u ? cnt : 1u;
}
__device__ __forceinline__ void xcd_barrier(const XcdBarrier& b) {
    asm volatile("s_waitcnt vmcnt(0)" ::: "memory");
    __syncthreads();
    if (threadIdx.x == 0) {
        unsigned* bar = b.bar;
        __builtin_amdgcn_s_waitcnt(0);
        unsigned nloc = b.st[0], nx = b.st[1];
        if (nloc == 0u) { xcd_barrier_complete(bar, b.x, nloc, nx); b.st[0] = nloc; b.st[1] = nx; }
        const unsigned old = xb_add(&bar[XB_XSUB(b.x)], 1u);
        const unsigned gen = old / nloc;
        if (old + 1u == (gen + 1u) * nloc) {
            __builtin_amdgcn_fence(__ATOMIC_RELEASE, "agent");
            asm volatile("s_waitcnt vmcnt(0)" ::: "memory");
            const unsigned og = xb_add(&bar[XB_TOP], 1u);
            const unsigned tg = og / nx;
            if (og + 1u == (tg + 1u) * nx) xb_add(&bar[XB_TOPGEN], 1u);
            else XB_SPIN(xb_ld(&bar[XB_TOPGEN]) == tg, bar);
            __builtin_amdgcn_fence(__ATOMIC_ACQUIRE, "agent");
            xb_add(&bar[XB_XGEN(b.x)], 1u);
            asm volatile("s_waitcnt vmcnt(0)" ::: "memory");
        } else {
            XB_SPIN(xb_ld(&bar[XB_XGEN(b.x)]) == gen, bar);
            __builtin_amdgcn_fence(__ATOMIC_ACQUIRE, "agent");
            asm volatile("s_waitcnt vmcnt(0)" ::: "memory");
        }
    }
    __syncthreads();
}

__device__ __forceinline__ float wave_sum(float v) {
#pragma unroll
    for (int o = 1; o < 64; o <<= 1) v += __shfl_xor(v, o);
    return v;
}
#define MFMA16(a, b, c) __builtin_amdgcn_mfma_f32_16x16x32_bf16((a), (b), (c), 0, 0, 0)
#define MFMA32(a, b, c) __builtin_amdgcn_mfma_f32_32x32x16_bf16((a), (b), (c), 0, 0, 0)
struct TJob { const float* W; bf16_t* WT; const float* gain; float scale; int ldw, Kd, nblk, kblk, scol, dbase, mode, start, nbatch; long sstride, dstride; };
constexpr int NJOBS = 14;
__device__ __forceinline__ int tj_drow(int mode, int dbase, int n) { if (mode & 4) return dbase + 256 * (n >> 7) + (n & 127);
    if (!(mode & 1)) return dbase + n; const int f = n >> 1, s = n & 1; return 256 * (f >> 7) + 128 * s + (f & 127); }
struct TRegs { f32x4 a[8], b[8]; };
__device__ __forceinline__ void tj_decode(const LAS TJob* jobs, int it, const float*& W, bf16_t*& WT, const float*& gain, float& scale, int& ldw, int& Kd, int& k0, int& n0, int& scol, int& dbase, int& mode) {
    int j = 0;
#pragma unroll 1
    for (int q = 1; q < NJOBS; ++q) if (it >= jobs[q].start) j = q;
    const LAS TJob& J = jobs[j]; int local = it - J.start; const int per = J.nblk * J.kblk; const int bt = local / per; local -= bt * per; const int kb = local / J.nblk, nb = local - kb * J.nblk;
    W = J.W + bt * J.sstride; WT = (bf16_t*)((char*)J.WT + bt * J.dstride); gain = J.gain; scale = J.scale; ldw = J.ldw; Kd = J.Kd; k0 = 64 * kb; n0 = 64 * nb; scol = J.scol; dbase = J.dbase; mode = J.mode;
}
#define TJ_LOAD(R, W, ldw, k0, scolx, lane, mode) do { const int rp_ = (lane) >> 4, c4_ = (lane) & 15; \
    _Pragma("unroll") for (int i = 0; i < 8; ++i) { const int P_ = ((mode) & 2) ? (8 * (i >> 1) + 2 * rp_ + (i & 1)) : (4 * i + rp_); const float* s_ = (W) + (size_t)((k0) + 2 * P_) * (ldw) + (scolx) + 4 * c4_; (R).a[i] = __builtin_nontemporal_load((const f32x4*)s_); (R).b[i] = __builtin_nontemporal_load((const f32x4*)(s_ + (ldw))); } } while (0)
__device__ __forceinline__ void tj_process(const TRegs& R, bf16_t* WT, int Kd, const float* gain, float scale, int k0, int n0, int dbase, int mode, LAS unsigned* scr, int lane) {
    const int rp = lane >> 4, c4 = lane & 15;
    if (mode & 2) {
        const int swz = 4 * (c4 & 3);
#pragma unroll
        for (int u = 0; u < 4; ++u) { const int Q = 4 * u + rp; float g0 = scale, g1 = scale, g2 = scale, g3 = scale;
            if (gain) { const f32x4 gv = *(const f32x4*)(gain + k0 + 4 * Q); g0 *= gv[0]; g1 *= gv[1]; g2 *= gv[2]; g3 *= gv[3]; }
#pragma unroll
            for (int t = 0; t < 4; ++t) scr[(4 * c4 + t) * 16 + (Q ^ swz)] = pk4_fp8(R.a[2 * u][t] * g0, R.b[2 * u][t] * g1, R.a[2 * u + 1][t] * g2, R.b[2 * u + 1][t] * g3); }
        asm volatile("s_waitcnt lgkmcnt(0)" ::: "memory");
#pragma unroll
        for (int j = 0; j < 4; ++j) { const int n = (lane >> 2) + 16 * j, ch = lane & 3; const u32x4 v = *(const LAS u32x4*)(scr + n * 16 + ((4 * ch) ^ (4 * ((n >> 2) & 3))));
            __builtin_nontemporal_store(v, (u32x4*)((char*)WT + (size_t)tj_drow(mode, dbase, n0 + n) * Kd + k0 + 16 * ch)); }
        asm volatile("s_waitcnt lgkmcnt(0)" ::: "memory");
        return;
    }
    const int swz = 4 * (c4 & 7);
#pragma unroll
    for (int i = 0; i < 8; ++i) { const int P = 4 * i + rp; float g0 = scale, g1 = scale; if (gain) { g0 *= gain[k0 + 2 * P]; g1 *= gain[k0 + 2 * P + 1]; }
#pragma unroll
        for (int t = 0; t < 4; ++t) scr[(4 * c4 + t) * 32 + (P ^ swz)] = pk2(R.a[i][t] * g0, R.b[i][t] * g1); }
    asm volatile("s_waitcnt lgkmcnt(0)" ::: "memory");
#pragma unroll
    for (int j = 0; j < 8; ++j) { const int n = (lane >> 3) + 8 * j, ch = lane & 7; const u32x4 v = *(const LAS u32x4*)(scr + n * 32 + ((4 * ch) ^ (4 * ((n >> 2) & 7))));
        *(u32x4*)(WT + (size_t)tj_drow(mode, dbase, n0 + n) * Kd + k0 + 8 * ch) = v; }
    asm volatile("s_waitcnt lgkmcnt(0)" ::: "memory");
}

__device__ __forceinline__ void gkl_row(const f32x4 (&v)[4], float rstd, const LAS float* GT, float* gkl_row_out, int lane) {
    float p[16];
#pragma unroll
    for (int r = 0; r < 16; ++r) { float a = 0.f;
#pragma unroll
        for (int j = 0; j < 4; ++j) { const f32x4 t = *(const LAS f32x4*)(GT + r * 1024 + 4 * (lane + 64 * j)); a += (v[j].x * t.x + v[j].y * t.y) + (v[j].z * t.z + v[j].w * t.w); }
        p[r] = a; if ((r & 1) == 1) asm volatile("" ::: "memory"); }
    const bool b5 = lane & 32, b4 = lane & 16, b3 = lane & 8, b2 = lane & 4;
    float q8[8], q4[4], q2[2];
#pragma unroll
    for (int r = 0; r < 8; ++r) { const float send = b5 ? p[r] : p[r + 8], keep = b5 ? p[r + 8] : p[r]; q8[r] = keep + __shfl_xor(send, 32); }
#pragma unroll
    for (int r = 0; r < 4; ++r) { const float send = b4 ? q8[r] : q8[r + 4], keep = b4 ? q8[r + 4] : q8[r]; q4[r] = keep + __shfl_xor(send, 16); }
#pragma unroll
    for (int r = 0; r < 2; ++r) { const float send = b3 ? q4[r] : q4[r + 2], keep = b3 ? q4[r + 2] : q4[r]; q2[r] = keep + __shfl_xor(send, 8); }
    float q1; { const float send = b2 ? q2[0] : q2[1], keep = b2 ? q2[1] : q2[0]; q1 = keep + __shfl_xor(send, 4); }
    q1 += __shfl_xor(q1, 2); q1 += __shfl_xor(q1, 1);
    if ((lane & 3) == 0) gkl_row_out[8 * (lane >> 5) + 4 * ((lane >> 4) & 1) + 2 * ((lane >> 3) & 1) + ((lane >> 2) & 1)] = q1 * rstd;
}
struct P0Args { const float *x, *p, *ln_mix, *w_in, *w_gk, *w_out, *ln_moe, *w_router, *w1, *b1, *w2, *ln_ple, *w_pg, *w_pp; unsigned char* ws; };

__device__ __forceinline__ void p0_prologue(const P0Args& a, LAS unsigned char* lds, int tid, int G, int vcu) {
    const int lane = tid & 63, wave = __builtin_amdgcn_readfirstlane(tid >> 6);
    LAS unsigned* scr = (LAS unsigned*)(lds + wave * 8192);
    LAS TJob* jobs = (LAS TJob*)(lds + 65536);
    const int gw = vcu * NWAVES + wave, NGW = G * NWAVES;
    bf16_t* WIN = (bf16_t*)(a.ws + WS_WIN); bf16_t* WIN8 = (bf16_t*)(a.ws + WS_WIN8);
    constexpr int DIN = 8208;
    const float C2 = 0.125f * LOG2E, QGS = 0.08838834764831845f;
    LAS float* GT = (LAS float*)(lds + 73728);
    for (int idx = tid; idx < 4096; idx += NWAVES * 64) { const int k = idx >> 2, part = idx & 3; const f32x4 wv = *(const f32x4*)(a.w_in + (size_t)k * DIN + 2048 + 4 * part); const float g = a.ln_mix[k];
#pragma unroll
        for (int i = 0; i < 4; ++i) GT[(4 * part + i) * 1024 + k] = wv[i] * g; }
    if (tid == 0) {
        int st = 0;
        auto add = [&](int j, const float* W, bf16_t* WT, const float* gain, float scale, int ldw, int Kd, int ncols, int Krows, int scol, int dbase, int mode, int nbatch, long ss, long ds) {
            LAS TJob* J = jobs + j; J->W = W; J->WT = WT; J->gain = gain; J->scale = scale; J->ldw = ldw; J->Kd = Kd; J->nblk = ncols / 64; J->kblk = Krows / 64; J->scol = scol; J->dbase = dbase; J->mode = mode; J->start = st; J->nbatch = nbatch; J->sstride = ss; J->dstride = ds;
            st += (ncols / 64) * (Krows / 64) * nbatch; };
        add(0, a.w1, (bf16_t*)(a.ws + WS_W1), a.ln_moe, WSCALE, 2048, D, 2048, D, 0, 0, 3, NEXP, (long)D * 2048, (long)2048 * D);
        add(1, a.w2, (bf16_t*)(a.ws + WS_W2), nullptr, WSCALE, D, D, D, D, 0, 0, 2, NEXP, (long)D * D, (long)D * D);
        add(2, a.w_in, WIN, a.ln_mix, QGS, DIN, D, 512, D, 0, 0, 0, 1, 0, 0);
        add(3, a.w_in, WIN, a.ln_mix, 1.f, DIN, D, 512, D, 512, 512, 0, 1, 0, 0);
        add(4, a.w_in, WIN, a.ln_mix, 1.f, DIN, D, 1024, D, 2064, 1024, 0, 1, 0, 0);
        add(5, a.w_in, WIN8, a.ln_mix, WSCALE, DIN, D, 1024, D, 6160, 2048, 6, 1, 0, 0);
        add(6, a.w_in, WIN8, a.ln_mix, WSCALE, DIN, D, 1024, D, 1024, 4096, 2, 1, 0, 0);
        add(7, a.w_in, WIN8, a.ln_mix, C2 * WSCALE, DIN, D, 1024, D, 3088, 0, 2, 1, 0, 0);
        add(8, a.w_in, WIN8, a.ln_mix, WSCALE, DIN, D, 1024, D, 4112, 1024, 2, 1, 0, 0);
        add(9, a.w_in, WIN8, a.ln_mix, WSCALE, DIN, D, 1024, D, 7184, 2048 + 128, 6, 1, 0, 0);
        add(10, a.w_in, WIN8, a.ln_mix, WSCALE, DIN, D, 1024, D, 5136, 5120, 2, 1, 0, 0);
        add(11, a.w_out, (bf16_t*)(a.ws + WS_WOUT), nullptr, 1.f, D, D, D, D, 0, 0, 0, 1, 0, 0);
        add(12, a.w_pg, (bf16_t*)(a.ws + WS_WPG), a.ln_ple, WSCALE, D, D, D, D, 0, 0, 2, 1, 0, 0);
        add(13, a.w_pp, (bf16_t*)(a.ws + WS_WPP), nullptr, 1.f, D, 256, D, 256, 0, 0, 0, 1, 0, 0);
        *(LAS int*)(lds + 65536 + 2048) = st;
    }
    __syncthreads();
    const int nitems = *(LAS int*)(lds + 65536 + 2048);
    {
        TRegs RA, RB; const float *Wa, *ga, *Wb, *gb; bf16_t *Ta, *Tb; float sa, sb; int la, Ka, k0a, n0a, sca, dba, ma, lb, Kb, k0b, n0b, scb, dbb, mb;
        int it = gw;
        if (it < nitems) { tj_decode(jobs, it, Wa, Ta, ga, sa, la, Ka, k0a, n0a, sca, dba, ma); TJ_LOAD(RA, Wa, la, k0a, sca + n0a, lane, ma); }
        while (it < nitems) {
            int nx = it + NGW;
            if (nx < nitems) { tj_decode(jobs, nx, Wb, Tb, gb, sb, lb, Kb, k0b, n0b, scb, dbb, mb); TJ_LOAD(RB, Wb, lb, k0b, scb + n0b, lane, mb); }
            tj_process(RA, Ta, Ka, ga, sa, k0a, n0a, dba, ma, scr, lane);
            it = nx; if (it >= nitems) break;
            nx = it + NGW;
            if (nx < nitems) { tj_decode(jobs, nx, Wa, Ta, ga, sa, la, Ka, k0a, n0a, sca, dba, ma); TJ_LOAD(RA, Wa, la, k0a, sca + n0a, lane, ma); }
            tj_process(RB, Tb, Kb, gb, sb, k0b, n0b, dbb, mb, scr, lane);
            it = nx;
        }
    }
    const int gt = vcu * (NWAVES * 64) + tid, NGT = G * NWAVES * 64;
    { bf16_t* WRH = (bf16_t*)(a.ws + WS_WRH); bf16_t* WRL = (bf16_t*)(a.ws + WS_WRL);
      for (int idx = gt; idx < NEXP * D; idx += NGT) { const int e = idx >> 10, k = idx & 1023; const float v = a.w_router[k * NEXP + e] * a.ln_moe[k];
          const unsigned h = pk2(v, 0.f) & 0xffffu; const float lo = v - __uint_as_float(h << 16); WRH[idx] = (bf16_t)h; WRL[idx] = (bf16_t)(pk2(lo, 0.f) & 0xffffu); } }
    { float* B1P = (float*)(a.ws + WS_B1P);
      for (int idx = gt; idx < NEXP * 2048; idx += NGT) { const int e = idx >> 11, r = idx & 2047, t = r >> 8, s = (r >> 7) & 1, j = r & 127; B1P[idx] = a.b1[e * 2048 + 2 * (128 * t + j) + s]; } }
    { bf16_t* XN = (bf16_t*)(a.ws + WS_XN); float* GKL = (float*)(a.ws + WS_GKL);
      for (int m = gw; m < NTOK; m += 2 * NGW) { const int m2 = m + NGW; const bool has2 = m2 < NTOK;
          const f32x4* xr = (const f32x4*)(a.x + (size_t)m * D) + lane; const f32x4* xr2 = (const f32x4*)(a.x + (size_t)(has2 ? m2 : m) * D) + lane; f32x4 v[4], w[4]; float s = 0.f, s2 = 0.f;
#pragma unroll
          for (int j = 0; j < 4; ++j) { v[j] = __builtin_nontemporal_load(xr + 64 * j); w[j] = __builtin_nontemporal_load(xr2 + 64 * j); }
#pragma unroll
          for (int j = 0; j < 4; ++j) { s += (v[j].x * v[j].x + v[j].y * v[j].y) + (v[j].z * v[j].z + v[j].w * v[j].w); s2 += (w[j].x * w[j].x + w[j].y * w[j].y) + (w[j].z * w[j].z + w[j].w * w[j].w); }
          const float rstd = 1.0f / sqrtf(wave_sum(s) * (1.f / D) + EPS), rstd2 = 1.0f / sqrtf(wave_sum(s2) * (1.f / D) + EPS);
          gkl_row(v, rstd, GT, GKL + (size_t)m * 16, lane); if (has2) gkl_row(w, rstd2, GT, GKL + (size_t)m2 * 16, lane);
          u32x2* o8 = (u32x2*)(XN + (size_t)m * D) + lane; unsigned* q8 = (unsigned*)(a.ws + WS_XN8 + (size_t)m * D) + lane;
#pragma unroll
          for (int j = 0; j < 4; ++j) { o8[64 * j] = (u32x2){pk2(v[j].x * rstd, v[j].y * rstd), pk2(v[j].z * rstd, v[j].w * rstd)}; q8[64 * j] = pk4_fp8(v[j].x * rstd, v[j].y * rstd, v[j].z * rstd, v[j].w * rstd); }
          if (has2) { u32x2* o9 = (u32x2*)(XN + (size_t)m2 * D) + lane; unsigned* q9 = (unsigned*)(a.ws + WS_XN8 + (size_t)m2 * D) + lane;
#pragma unroll
              for (int j = 0; j < 4; ++j) { o9[64 * j] = (u32x2){pk2(w[j].x * rstd2, w[j].y * rstd2), pk2(w[j].z * rstd2, w[j].w * rstd2)}; q9[64 * j] = pk4_fp8(w[j].x * rstd2, w[j].y * rstd2, w[j].z * rstd2, w[j].w * rstd2); } } } }
    { u32x2* PB = (u32x2*)(a.ws + WS_PB); const f32x4* p4 = (const f32x4*)a.p;
      for (int i = gt; i < NTOK * 256 / 4; i += NGT) { const f32x4 v = __builtin_nontemporal_load(p4 + i); PB[i] = (u32x2){pk2(v.x, v.y), pk2(v.z, v.w)}; } }
}

#define DPP_ROR8 0x128
__device__ __forceinline__ void adj_pair(const u32x4 U, const u32x4 V, u32x4& I1, u32x4& I2) {
#pragma unroll
    for (int c = 0; c < 4; ++c) { I2[c] = (unsigned)__builtin_amdgcn_update_dpp((int)V[c], (int)U[c], DPP_ROR8, 0xF, 0x3, false); I1[c] = (unsigned)__builtin_amdgcn_update_dpp((int)U[c], (int)V[c], DPP_ROR8, 0xF, 0xC, false); }
}
__device__ __forceinline__ void adj_pair2(const u32x2 U, const u32x2 V, u32x2& I1, u32x2& I2) {
#pragma unroll
    for (int c = 0; c < 2; ++c) { I2[c] = (unsigned)__builtin_amdgcn_update_dpp((int)V[c], (int)U[c], DPP_ROR8, 0xF, 0x3, false); I1[c] = (unsigned)__builtin_amdgcn_update_dpp((int)U[c], (int)V[c], DPP_ROR8, 0xF, 0xC, false); }
}
template <int MODE> struct EpiZ {
    static constexpr bool PERM = true, ADJ = true; static constexpr int NSTORE = 16;
    bf16_t* z512; bf16_t* z1024; int rowmask;
    __device__ __forceinline__ void operator()(const f32x4 (&acc)[2][2][4][2], const pg8::Unit& u, int wr, int wc, int fr, int fq) const {
        bf16_t* base; int ld, colt; float sc = 1.0f;
        if (MODE == 0) {
            if (u.pn < 4) { base = z512 + (size_t)(u.pn >> 1) * ((size_t)NTOK * 512); ld = 512; colt = (u.pn & 1) * 256; }
            else { const int q = u.pn - 4; base = z1024; ld = 1024; colt = (q & 3) * 256; }
        } else { base = z1024 + (size_t)(1 + (u.pn >> 2)) * ((size_t)NTOK * 1024); ld = 1024; colt = (u.pn & 3) * 256; sc = 1.0f / WSCALE; }
        const int row0 = (u.pm * 256 + wr * 64 + (fr & 7)) & rowmask, col0 = colt + wc * 64 + 8 * (fq + 4 * (fr >> 3));
#pragma unroll
        for (int ai = 0; ai < 2; ++ai)
#pragma unroll
            for (int m = 0; m < 4; ++m) { bf16_t* rowp = base + (size_t)(row0 + ai * 128 + m * 16) * ld + col0;
                const f32x4 a0 = acc[ai][0][m][0] * sc, a1 = acc[ai][0][m][1] * sc, b0 = acc[ai][1][m][0] * sc, b1 = acc[ai][1][m][1] * sc;
                const u32x4 U = (u32x4){pk2(a0[0], a0[1]), pk2(a0[2], a0[3]), pk2(a1[0], a1[1]), pk2(a1[2], a1[3])}, V = (u32x4){pk2(b0[0], b0[1]), pk2(b0[2], b0[3]), pk2(b1[0], b1[1]), pk2(b1[2], b1[3])};
                u32x4 I1, I2; adj_pair(U, V, I1, I2);
                __builtin_nontemporal_store(I1, (u32x4*)rowp); __builtin_nontemporal_store(I2, (u32x4*)(rowp + (size_t)8 * ld)); }
    }
};
__device__ __forceinline__ unsigned sig4_u8(const f32x4 v) {
    unsigned q[4];
#pragma unroll
    for (int i = 0; i < 4; ++i) q[i] = (unsigned)(255.0f * fast_rcp(1.0f + fast_exp2(v[i] * (-LOG2E / WSCALE))) + 0.5f);
    return q[0] | (q[1] << 8) | (q[2] << 16) | (q[3] << 24);
}
struct EpiG {
    static constexpr bool PERM = true; static constexpr int NSTORE = 8;
    unsigned char* g8;
    __device__ __forceinline__ void operator()(const f32x4 (&acc)[2][2][4][2], const pg8::Unit& u, int wr, int wc, int fr, int fq) const {
        unsigned char* const base = g8 + (size_t)(u.pm * 256 + wr * 64 + fr) * 2048 + (16 * u.pn + 4 * wc + fq) * 16;
#pragma unroll
        for (int ai = 0; ai < 2; ++ai)
#pragma unroll
            for (int m = 0; m < 4; ++m)
                __builtin_nontemporal_store(((u32x4){sig4_u8(acc[ai][0][m][0]), sig4_u8(acc[ai][0][m][1]), sig4_u8(acc[ai][1][m][0]), sig4_u8(acc[ai][1][m][1])}), (u32x4*)(base + (size_t)(ai * 128 + m * 16) * 2048));
    }
};
struct EpiB {
    static constexpr bool PERM = true, ADJ = true;
    unsigned char* O; int ldc; float sc;
    __device__ __forceinline__ void operator()(const f32x4 (&acc)[2][2][4][2], const pg8::Unit& u, int wr, int wc, int fr, int fq) const {
        const int row0 = u.pm * 256 + wr * 64 + (fr & 7), col0 = u.pn * 256 + wc * 64 + 8 * (fq + 4 * (fr >> 3));
#pragma unroll
        for (int ai = 0; ai < 2; ++ai)
#pragma unroll
            for (int m = 0; m < 4; ++m) { unsigned char* rowp = O + (size_t)(row0 + ai * 128 + m * 16) * ldc + col0;
                const f32x4 a0 = acc[ai][0][m][0] * sc, a1 = acc[ai][0][m][1] * sc, b0 = acc[ai][1][m][0] * sc, b1 = acc[ai][1][m][1] * sc;
                const unsigned U0 = pk4_fp8(a0[0], a0[1], a0[2], a0[3]), U1 = pk4_fp8(a1[0], a1[1], a1[2], a1[3]), V0 = pk4_fp8(b0[0], b0[1], b0[2], b0[3]), V1 = pk4_fp8(b1[0], b1[1], b1[2], b1[3]);
                const unsigned J0 = (unsigned)__builtin_amdgcn_update_dpp((int)V0, (int)U0, DPP_ROR8, 0xF, 0x3, false), J1 = (unsigned)__builtin_amdgcn_update_dpp((int)V1, (int)U1, DPP_ROR8, 0xF, 0x3, false);
                const unsigned I0 = (unsigned)__builtin_amdgcn_update_dpp((int)U0, (int)V0, DPP_ROR8, 0xF, 0xC, false), I1 = (unsigned)__builtin_amdgcn_update_dpp((int)U1, (int)V1, DPP_ROR8, 0xF, 0xC, false);
                __builtin_nontemporal_store(((u32x2){I0, I1}), (u32x2*)rowp); __builtin_nontemporal_store(((u32x2){J0, J1}), (u32x2*)(rowp + (size_t)8 * ldc)); }
    }
};
struct EpiVT {
    static constexpr bool PERM = true, ADJ = true; static constexpr int NSTORE = 16;
    bf16_t* O; int rowbase; float sc;
    __device__ __forceinline__ void operator()(const f32x4 (&acc)[2][2][4][2], const pg8::Unit& u, int wr, int wc, int fr, int fq) const {
        const int row0 = rowbase + u.pm * 256 + wr * 64 + (fr & 7);
        const unsigned off0 = (unsigned)((((u.pn * 4 + wc) * 2048 + row0) * 64 + 8 * (fq + 4 * (fr >> 3))) * 2);
        char* const base = (char*)O;
#pragma unroll
        for (int ai = 0; ai < 2; ++ai)
#pragma unroll
            for (int m = 0; m < 4; ++m) {
                const f32x4 a0 = acc[ai][0][m][0] * sc, a1 = acc[ai][0][m][1] * sc, b0 = acc[ai][1][m][0] * sc, b1 = acc[ai][1][m][1] * sc;
                const u32x4 U = (u32x4){pk2(a0[0], a0[1]), pk2(a0[2], a0[3]), pk2(a1[0], a1[1]), pk2(a1[2], a1[3])}, V = (u32x4){pk2(b0[0], b0[1]), pk2(b0[2], b0[3]), pk2(b1[0], b1[1]), pk2(b1[2], b1[3])};
                u32x4 I1, I2; adj_pair(U, V, I1, I2);
                __builtin_nontemporal_store(I1, (u32x4*)(base + (off0 + (unsigned)((ai * 128 + m * 16) * 128)))); __builtin_nontemporal_store(I2, (u32x4*)(base + (off0 + (unsigned)((ai * 128 + m * 16 + 8) * 128))));
                asm volatile("" ::: "memory"); }
    }
};
struct EpiX1 {
    static constexpr bool PERM = true, ADJ = true;
    const float* x; bf16_t* x1b; unsigned char* xb;
    __device__ __forceinline__ void operator()(const f32x4 (&acc)[2][2][4][2], const pg8::Unit& u, int wr, int wc, int fr, int fq) const {
        const int rowt = u.pm * 256 + wr * 64, colw = u.pn * 256 + wc * 64;
        const int ocol = colw + 8 * (fq + 4 * (fr >> 3));
        f32x4 xv[4][2][2];
#define X1_LOAD(ai_, m_) do { _Pragma("unroll") for (int bj = 0; bj < 2; ++bj) _Pragma("unroll") for (int n = 0; n < 2; ++n) \
            xv[m_][bj][n] = __builtin_nontemporal_load((const f32x4*)(x + (size_t)(rowt + fr + (ai_) * 128 + (m_) * 16) * D + colw + bj * 32 + 8 * fq + n * 4)); } while (0)
#pragma unroll
        for (int m = 0; m < 4; ++m) X1_LOAD(0, m);
#pragma unroll
        for (int ai = 0; ai < 2; ++ai) {
#pragma unroll
            for (int m = 0; m < 4; ++m) { const size_t o = (size_t)(rowt + (fr & 7) + ai * 128 + m * 16) * D + ocol;
                const f32x4 a0 = xv[m][0][0] + acc[ai][0][m][0], a1 = xv[m][0][1] + acc[ai][0][m][1], b0 = xv[m][1][0] + acc[ai][1][m][0], b1 = xv[m][1][1] + acc[ai][1][m][1];
                asm volatile("" ::: "memory");
                if (ai == 0) X1_LOAD(1, m);
                const u32x4 U = (u32x4){pk2(a0[0], a0[1]), pk2(a0[2], a0[3]), pk2(a1[0], a1[1]), pk2(a1[2], a1[3])}, V = (u32x4){pk2(b0[0], b0[1]), pk2(b0[2], b0[3]), pk2(b1[0], b1[1]), pk2(b1[2], b1[3])};
                const u32x2 U8 = (u32x2){pk4_fp8(a0[0], a0[1], a0[2], a0[3]), pk4_fp8(a1[0], a1[1], a1[2], a1[3])}, V8 = (u32x2){pk4_fp8(b0[0], b0[1], b0[2], b0[3]), pk4_fp8(b1[0], b1[1], b1[2], b1[3])};
                u32x4 I1, I2; adj_pair(U, V, I1, I2); u32x2 J1, J2; adj_pair2(U8, V8, J1, J2);
                *(u32x4*)(x1b + o) = I1; *(u32x4*)(x1b + o + 8 * D) = I2; *(u32x2*)(xb + o) = J1; *(u32x2*)(xb + o + 8 * D) = J2;
                asm volatile("" ::: "memory"); }
        }
#undef X1_LOAD
    }
};
struct EpiSwiglu {
    static constexpr bool PERM = true;
    const float* rstd_slot; const float* b1p; unsigned char* act;
    __device__ __forceinline__ void operator()(const f32x4 (&acc)[2][2][4][2], const pg8::Unit& u, int wr, int wc, int fr, int fq) const {
        const int e = u.pn >> 3, pnl = u.pn & 7; const int row0 = u.pm * 256 + wr * 64 + fr, j0 = wc * 32 + 8 * fq;
        const float* bb = b1p + e * 2048 + pnl * 256 + j0;
        const f32x4 bg0 = *(const f32x4*)(bb), bg1 = *(const f32x4*)(bb + 4), bl0 = *(const f32x4*)(bb + 128), bl1 = *(const f32x4*)(bb + 132);
        float rsv[2][4];
#pragma unroll
        for (int ai = 0; ai < 2; ++ai)
#pragma unroll
            for (int m = 0; m < 4; ++m) rsv[ai][m] = rstd_slot[row0 + ai * 128 + m * 16] * (1.0f / WSCALE);
#pragma unroll
        for (int ai = 0; ai < 2; ++ai)
#pragma unroll
            for (int m = 0; m < 4; ++m) { const int row = row0 + ai * 128 + m * 16; const float rs = rsv[ai][m];
                unsigned w[2];
#pragma unroll
                for (int n = 0; n < 2; ++n) { const f32x4 g4 = acc[ai][0][m][n] * rs + (n ? bg1 : bg0), l4 = acc[ai][1][m][n] * rs + (n ? bl1 : bl0); f32x4 xg, xl, den;
#pragma unroll
                    for (int i = 0; i < 4; ++i) { xg[i] = fminf(g4[i], 7.0f); xl[i] = __builtin_amdgcn_fmed3f(l4[i], -7.0f, 7.0f); }
                    const f32x4 ex = xg * (-1.702f * LOG2E);
#pragma unroll
                    for (int i = 0; i < 4; ++i) den[i] = fast_exp2(ex[i]);
                    den = den + 1.0f;
#pragma unroll
                    for (int i = 0; i < 4; ++i) den[i] = fast_rcp(den[i]);
                    const f32x4 r = xg * (xl * ASCALE + ASCALE) * den;
                    w[n] = pk4_fp8(r[0], r[1], r[2], r[3]); }
                *(u32x2*)(act + (size_t)row * D + pnl * 128 + j0) = (u32x2){w[0], w[1]};        }
    }
};
struct EpiY {
    static constexpr bool PERM = true; static constexpr int NSTORE = 8;
    const float* gate_slot; const float* b2; unsigned char* ys; LAS unsigned char* stage;
    __device__ __forceinline__ void operator()(const f32x4 (&acc)[2][2][4][2], const pg8::Unit& u, int wr, int wc, int fr, int fq) const {
        const int e = u.pn >> 2, pnl = u.pn & 3; const int row0 = u.pm * 256 + wr * 64 + fr, col0 = pnl * 256 + wc * 32 + 8 * fq;
        f32x4 bv[2][2];
#pragma unroll
        for (int bj = 0; bj < 2; ++bj)
#pragma unroll
            for (int n = 0; n < 2; ++n) bv[bj][n] = *(const f32x4*)(b2 + e * D + col0 + bj * 128 + 4 * n);
        float gtv[2][4];
#pragma unroll
        for (int ai = 0; ai < 2; ++ai)
#pragma unroll
            for (int m = 0; m < 4; ++m) gtv[ai][m] = gate_slot[row0 + ai * 128 + m * 16];
        const int t = threadIdx.x, lr = t >> 4, ch = t & 15;
#pragma unroll
        for (int ai = 0; ai < 2; ++ai)
#pragma unroll
            for (int m = 0; m < 4; ++m) { const float gt = gtv[ai][m] * YSCALE; LAS unsigned char* sb = stage + ((ai * 4 + m) & 1) * (32 * 272);
#pragma unroll
                for (int bj = 0; bj < 2; ++bj) { const f32x4 v0 = (acc[ai][bj][m][0] * (1.0f / (WSCALE * ASCALE)) + bv[bj][0]) * gt, v1 = (acc[ai][bj][m][1] * (1.0f / (WSCALE * ASCALE)) + bv[bj][1]) * gt;
                    *(LAS u32x2*)(sb + (wr * 16 + fr) * 272 + bj * 128 + wc * 32 + 8 * fq) = (u32x2){pk4_fp8(v0[0], v0[1], v0[2], v0[3]), pk4_fp8(v1[0], v1[1], v1[2], v1[3])}; }
                asm volatile("s_waitcnt lgkmcnt(0)" ::: "memory"); __builtin_amdgcn_s_barrier(); asm volatile("" ::: "memory");
                const u32x4 w = *(const LAS u32x4*)(sb + lr * 272 + ch * 16);
                *(u32x4*)(ys + (size_t)(u.pm * 256 + ai * 128 + (lr >> 4) * 64 + m * 16 + (lr & 15)) * D + pnl * 256 + ch * 16) = w; }
    }
};
__device__ __forceinline__ unsigned sig4_u8k(const f32x4 v, float k) {
    unsigned q[4];
#pragma unroll
    for (int i = 0; i < 4; ++i) q[i] = (unsigned)(255.0f * fast_rcp(1.0f + fast_exp2(v[i] * k)) + 0.5f);
    return q[0] | (q[1] << 8) | (q[2] << 16) | (q[3] << 24);
}
struct EpiPle {
    static constexpr bool PERM = true, ADJ = true;
    const float* rstd2; unsigned char* gate;
    __device__ __forceinline__ void operator()(const f32x4 (&acc)[2][2][4][2], const pg8::Unit& u, int wr, int wc, int fr, int fq) const {
        const int rowt = u.pm * 256 + wr * 64, ocol = u.pn * 256 + wc * 64 + 8 * (fq + 4 * (fr >> 3));
        float rsv[2][4];
#pragma unroll
        for (int ai = 0; ai < 2; ++ai)
#pragma unroll
            for (int m = 0; m < 4; ++m) rsv[ai][m] = rstd2[rowt + fr + ai * 128 + m * 16] * (-LOG2E / WSCALE);
#pragma unroll
        for (int ai = 0; ai < 2; ++ai)
#pragma unroll
            for (int m = 0; m < 4; ++m) { const float k = rsv[ai][m];
                const u32x2 U8 = (u32x2){sig4_u8k(acc[ai][0][m][0], k), sig4_u8k(acc[ai][0][m][1], k)}, V8 = (u32x2){sig4_u8k(acc[ai][1][m][0], k), sig4_u8k(acc[ai][1][m][1], k)};
                u32x2 J1, J2; adj_pair2(U8, V8, J1, J2);
                unsigned char* o = gate + (size_t)(rowt + (fr & 7) + ai * 128 + m * 16) * D + ocol; *(u32x2*)o = J1; *(u32x2*)(o + 8 * D) = J2; }
    }
};
__device__ __forceinline__ float logsigmoid_(float x) { return fminf(x, 0.f) - 0.6931471805599453f * __builtin_amdgcn_logf(1.0f + fast_exp2(-LOG2E * fabsf(x))); }
__device__ __forceinline__ void gla_pre(LAS unsigned char* lds, bf16_t* QG, const bf16_t* KG, const float* GKL, const float* __restrict__ w_gk, const float* __restrict__ b_gk,
                                        bf16_t* KTT, float* DL, bf16_t* AT, int G, int bid, int tid) {
    const int lane = tid & 63, wid = __builtin_amdgcn_readfirstlane(tid >> 6), l15 = lane & 15, lq = lane >> 4;
    constexpr int QS_OFF = 0, KM_OFF = 16640, KP_OFF = 33280, AM_OFF = 51712, SEG_OFF = 60928;
    LAS unsigned char* QS = lds + QS_OFF; LAS unsigned char* KM = lds + KM_OFF; LAS unsigned char* KP = lds + KP_OFF; LAS unsigned char* AM = lds + AM_OFF; LAS float* SEGT = (LAS float*)(lds + SEG_OFF);
    const int dp = lane, seg = wid;
#define GP_BAR() do { asm volatile("s_waitcnt lgkmcnt(0)" ::: "memory"); __builtin_amdgcn_s_barrier(); asm volatile("" ::: "memory"); } while (0)
#define GP_LOAD_QKU(uu) do { const int b_ = (uu) >> 8, c_ = ((uu) >> 2) & 63, hg_ = (uu) & 3; \
        gkv = __builtin_nontemporal_load((const f32x2*)(GKL + (size_t)(b_ * TSEQ + c_ * 64 + 8 * seg + (lane >> 3)) * 16 + 2 * (lane & 7)));     \
        _Pragma("unroll") for (int i = 0; i < 8; ++i) { const size_t off = (size_t)(b_ * TSEQ + c_ * 64 + 8 * seg + i) * 512 + hg_ * 128 + 2 * dp; \
            qw[i] = __builtin_nontemporal_load((const unsigned*)(QG + off)); kw[i] = __builtin_nontemporal_load((const unsigned*)(KG + off)); } } while (0)
    unsigned qw[8], kw[8]; f32x2 gkv, wg[16]; int hg_w = -1;
    if (bid < NB * NCH * 4) { GP_LOAD_QKU(bid); }
    for (int u = bid; u < NB * NCH * 4; u += G) {
        const int b = u >> 8, c = (u >> 2) & 63, hg = u & 3;
        const int tok0 = b * TSEQ + c * 64;
        const int un = u + G; const bool hasn = un < NB * NCH * 4;
        const float bias0 = b_gk[hg * 128 + 2 * dp], bias1 = b_gk[hg * 128 + 2 * dp + 1];
        if (hg != hg_w) {
#pragma unroll
            for (int r = 0; r < 16; ++r) wg[r] = *(const f32x2*)(w_gk + r * 512 + hg * 128 + 2 * dp);
            hg_w = hg; }
        float cum0[8], cum1[8]; float run0 = 0.f, run1 = 0.f;
#pragma unroll
        for (int i = 0; i < 8; ++i) { float u0 = bias0, u1 = bias1;
#pragma unroll
            for (int r = 0; r < 16; ++r) { const float g = __int_as_float(__builtin_amdgcn_readlane(__float_as_int((r & 1) ? gkv.y : gkv.x), 8 * i + (r >> 1))); u0 += g * wg[r].x; u1 += g * wg[r].y; }
            run0 += logsigmoid_(u0) * 0.0625f; run1 += logsigmoid_(u1) * 0.0625f; cum0[i] = run0; cum1[i] = run1; }
        *(LAS f32x2*)(SEGT + seg * 128 + 2 * dp) = (f32x2){run0, run1};
        GP_BAR();
        float off0 = 0.f, off1 = 0.f, tot0 = 0.f, tot1 = 0.f;
#pragma unroll
        for (int s = 0; s < 8; ++s) { const f32x2 v = *(const LAS f32x2*)(SEGT + s * 128 + 2 * dp); if (s < seg) { off0 += v.x; off1 += v.y; } tot0 += v.x; tot1 += v.y; }
        unsigned kpa[4], kpb[4]; float kp0p = 0.f, kp1p = 0.f;
#pragma unroll
        for (int i = 0; i < 8; ++i) { const float b0 = (cum0[i] + off0) * LOG2E, b1 = (cum1[i] + off1) * LOG2E;
            const float e0 = fast_exp2(b0), e1 = fast_exp2(b1), em0 = fast_exp2(-b0), em1 = fast_exp2(-b1), ep0 = fast_exp2(tot0 * LOG2E - b0), ep1 = fast_exp2(tot1 * LOG2E - b1);
            const float q0 = bf_lo(qw[i]), q1 = bf_hi(qw[i]), k0 = bf_lo(kw[i]), k1 = bf_hi(kw[i]);
            const unsigned qt = pk2(q0 * e0, q1 * e1), km = pk2(k0 * em0, k1 * em1);
            const int t = 8 * seg + i; const size_t off = (size_t)(tok0 + t) * 512 + hg * 128 + 2 * dp;
            *(unsigned*)(QG + off) = qt;
            const int la = (dp >> 2) * 1040 + t * 16 + (dp & 3) * 4;
            *(LAS unsigned*)(QS + la) = qt; *(LAS unsigned*)(KM + la) = km;
            const float kp0 = k0 * ep0, kp1 = k1 * ep1;
            if (i & 1) { kpa[i >> 1] = pk2(kp0p, kp0); kpb[i >> 1] = pk2(kp1p, kp1); } else { kp0p = kp0; kp1p = kp1; } }
        *(LAS u32x4*)(KP + (2 * dp) * 144 + 16 * seg) = (u32x4){kpa[0], kpa[1], kpa[2], kpa[3]};
        *(LAS u32x4*)(KP + (2 * dp + 1) * 144 + 16 * seg) = (u32x4){kpb[0], kpb[1], kpb[2], kpb[3]};
        if (seg == 0) *(f32x2*)(DL + (size_t)u * 128 + 2 * dp) = (f32x2){fast_exp2(tot0 * LOG2E), fast_exp2(tot1 * LOG2E)};
        if (hasn) GP_LOAD_QKU(un);
        GP_BAR();
#pragma unroll
        for (int j = 0; j < 2; ++j) { const int ch = tid + 512 * j, dk = ch >> 3, part = ch & 7; *(u32x4*)(KTT + (size_t)u * 8192 + ch * 8) = *(const LAS u32x4*)(KP + dk * 144 + part * 16); }
        { const int st = wid >> 1, ttb = 2 * (wid & 1); f32x4 d1[2] = {(f32x4){0.f, 0.f, 0.f, 0.f}, (f32x4){0.f, 0.f, 0.f, 0.f}};
#pragma unroll
          for (int kk = 0; kk < 4; ++kk) { const int chunk = 4 * kk + lq; const bf16x8 af = *(const LAS bf16x8*)(KM + chunk * 1040 + (16 * st + l15) * 16);
#pragma unroll
              for (int x = 0; x < 2; ++x) { const bf16x8 bfr = *(const LAS bf16x8*)(QS + chunk * 1040 + (16 * (ttb + x) + l15) * 16); d1[x] = MFMA16(af, bfr, d1[x]); } }
#pragma unroll
          for (int x = 0; x < 2; ++x) { const int t = 16 * (ttb + x) + l15, s0 = 16 * st + 4 * lq; float v[4];
#pragma unroll
              for (int i = 0; i < 4; ++i) v[i] = (t >= s0 + i) ? d1[x][i] : 0.f;
              *(LAS u32x2*)(AM + t * 144 + s0 * 2) = (u32x2){pk2(v[0], v[1]), pk2(v[2], v[3])}; } }
        GP_BAR();
        { const int t = tid >> 3, part = tid & 7; *(u32x4*)(AT + (size_t)u * 4096 + t * 64 + part * 8) = *(const LAS u32x4*)(AM + t * 144 + part * 16); }
        GP_BAR();
    }
    asm volatile("s_waitcnt vmcnt(0)" ::: "memory");
#undef GP_BAR
#undef GP_LOAD_QKU
}

__device__ __forceinline__ void gla_scan(LAS unsigned char* lds, const bf16_t* QT, const bf16_t* KTT, const bf16_t* VGT, const bf16_t* AT, const float* DL, bf16_t* OG, float* OGSS, int G, int bid, int tid, int variant) {
    const int lane = tid & 63, wid = __builtin_amdgcn_readfirstlane(tid >> 6), l15 = lane & 15, lq = lane >> 4;
    const int dvt = wid & 1, tt = wid >> 1;
    constexpr int STG = 45056, ST_OFF = 3 * 45056, STB = 32 * 272;
    int qoff[4], koff[2], voff[2][2], vooff[2], aoff[2];
#pragma unroll
    for (int kk = 0; kk < 4; ++kk) qoff[kk] = (16 * tt + l15) * 256 + (((4 * kk + lq) ^ l15) << 4);
#pragma unroll
    for (int kk = 0; kk < 2; ++kk) { const int dk = 16 * wid + l15; koff[kk] = 16384 + dk * 128 + (((4 * kk + lq) ^ ((dk >> 1) & 7)) << 4);
#pragma unroll
        for (int nt = 0; nt < 2; ++nt) { const int dv = 16 * nt + l15; voff[nt][kk] = 32768 + dv * 128 + (((4 * kk + lq) ^ ((dv >> 1) & 7)) << 4); } }
#pragma unroll
    for (int kk = 0; kk < 2; ++kk) { const int dv = 16 * dvt + l15, t = 16 * tt + l15; vooff[kk] = 32768 + dv * 128 + (((4 * kk + lq) ^ ((dv >> 1) & 7)) << 4); aoff[kk] = 36864 + t * 128 + (((4 * kk + lq) ^ ((t >> 1) & 7)) << 4); }
    for (int u = bid; u < NB * 4 * 8; u += G) {
        const int b = u >> 5, hg = (u >> 3) & 3, sl = u & 7;
        f32x4 S[2] = {(f32x4){0.f, 0.f, 0.f, 0.f}, (f32x4){0.f, 0.f, 0.f, 0.f}};
        for (int i = tid; i < STB / 16; i += 512) *(LAS u32x4*)(lds + ST_OFF + i * 16) = (u32x4){0u, 0u, 0u, 0u};
        bf16_t* op = OG + (size_t)(b * TSEQ + 16 * tt + l15) * D + hg * 256 + sl * 32 + 16 * dvt + 4 * lq;
        const float* dp = DL + (size_t)(b * 256 + hg) * 128 + 16 * wid + 4 * lq;
        float* ssp = OGSS + ((size_t)(b * TSEQ + 16 * tt + l15) * 4 + hg) * 16 + sl * 2 + dvt;
        const bf16_t* gq[2]; const bf16_t* gk[2]; const bf16_t* gv; const bf16_t* ga;
#pragma unroll
        for (int x = 0; x < 2; ++x) { const int j = 2 * wid + x;
            { const int row = 4 * j + (lane >> 4), ch = (lane & 15) ^ (row & 15); gq[x] = QT + (size_t)(b * TSEQ + row) * 512 + hg * 128 + 8 * ch; }
            { const int row = 8 * j + (lane >> 3), ch = (lane & 7) ^ ((row >> 1) & 7); gk[x] = KTT + (size_t)(b * 256 + hg) * 8192 + row * 64 + 8 * ch; } }
        { const int row = 8 * (wid & 3) + (lane >> 3), ch = (lane & 7) ^ ((row >> 1) & 7); gv = VGT + ((size_t)(b * NCH) * 2048 + hg * 256 + sl * 32 + row) * 64 + 8 * ch; }
        { const int row = 8 * wid + (lane >> 3), ch = (lane & 7) ^ ((row >> 1) & 7); ga = AT + (size_t)(b * 256 + hg) * 4096 + row * 64 + 8 * ch; }
        const size_t gvstep = (size_t)2048 * 64;
#define SCAN_DMA(c, sidx) do { if (!(variant & 2)) { LAS unsigned char* sb_ = lds + (sidx) * STG; \
        _Pragma("unroll") for (int x = 0; x < 2; ++x) { \
            __builtin_amdgcn_global_load_lds((const unsigned*)(gq[x] + (size_t)(c) * 64 * 512), (LAS unsigned*)(sb_ + (2 * wid + x) * 1024), 16, 0, 0); \
            __builtin_amdgcn_global_load_lds((const unsigned*)(gk[x] + (size_t)(c) * 4 * 8192), (LAS unsigned*)(sb_ + 16384 + (2 * wid + x) * 1024), 16, 0, 0); } \
        __builtin_amdgcn_global_load_lds((const unsigned*)(ga + (size_t)(c) * 4 * 4096), (LAS unsigned*)(sb_ + 36864 + wid * 1024), 16, 0, 0); \
        if (wid < 4) __builtin_amdgcn_global_load_lds((const unsigned*)(gv + (size_t)(c) * gvstep), (LAS unsigned*)(sb_ + 32768 + wid * 1024), 16, 0, 0); } } while (0)
#define SCAN_STEP(c, sidx, DV, WAITN) do { const LAS unsigned char* sb = lds + (sidx) * STG; \
        const LAS unsigned char* stc = lds + ST_OFF + ((c) & 1) * STB; LAS unsigned char* stn = lds + ST_OFF + (((c) & 1) ^ 1) * STB; \
          \
        bf16x8 fsa[4], fqb[4], fvo[2], fao[2], fka[2], fv0[2], fv1[2]; \
        _Pragma("unroll") for (int kk = 0; kk < 4; ++kk) { fsa[kk] = *(const LAS bf16x8*)(stc + (16 * dvt + l15) * 272 + (32 * kk + 8 * lq) * 2); fqb[kk] = *(const LAS bf16x8*)(sb + qoff[kk]); } \
        _Pragma("unroll") for (int kk = 0; kk < 2; ++kk) { fka[kk] = *(const LAS bf16x8*)(sb + koff[kk]); fv0[kk] = *(const LAS bf16x8*)(sb + voff[0][kk]); fv1[kk] = *(const LAS bf16x8*)(sb + voff[1][kk]); fvo[kk] = *(const LAS bf16x8*)(sb + vooff[kk]); fao[kk] = *(const LAS bf16x8*)(sb + aoff[kk]); } \
        __builtin_amdgcn_sched_barrier(0); \
          \
        f32x4 oT = (f32x4){0.f, 0.f, 0.f, 0.f}, oU = (f32x4){0.f, 0.f, 0.f, 0.f}, oV = (f32x4){0.f, 0.f, 0.f, 0.f}, dS0 = (f32x4){0.f, 0.f, 0.f, 0.f}, dS1 = (f32x4){0.f, 0.f, 0.f, 0.f}; \
        dS0 = MFMA16(fka[0], fv0[0], dS0); dS1 = MFMA16(fka[0], fv1[0], dS1); oT = MFMA16(fsa[0], fqb[0], oT); oU = MFMA16(fsa[1], fqb[1], oU); oV = MFMA16(fvo[0], fao[0], oV); \
        dS0 = MFMA16(fka[1], fv0[1], dS0); dS1 = MFMA16(fka[1], fv1[1], dS1); oT = MFMA16(fsa[2], fqb[2], oT); oU = MFMA16(fsa[3], fqb[3], oU); oV = MFMA16(fvo[1], fao[1], oV);     \
        __builtin_amdgcn_sched_barrier(0); \
        oT = oT + oU + oV; \
        S[0] = S[0] * DV + dS0; S[1] = S[1] * DV + dS1; \
        *(LAS u32x2*)(stn + (l15) * 272 + (16 * wid + 4 * lq) * 2) = (u32x2){pk2(S[0][0], S[0][1]), pk2(S[0][2], S[0][3])}; \
        *(LAS u32x2*)(stn + (16 + l15) * 272 + (16 * wid + 4 * lq) * 2) = (u32x2){pk2(S[1][0], S[1][1]), pk2(S[1][2], S[1][3])}; \
        const float o0 = oT[0], o1 = oT[1], o2 = oT[2], o3 = oT[3]; \
        if (!(variant & 4)) *(u32x2*)(op + (size_t)(c) * 64 * D) = (u32x2){pk2(o0, o1), pk2(o2, o3)}; \
        float ss = (o0 * o0 + o1 * o1) + (o2 * o2 + o3 * o3); ss += __shfl_xor(ss, 16); ss += __shfl_xor(ss, 32); \
        if (lane < 16 && !(variant & 4)) ssp[(size_t)(c) * 64 * 64] = ss; \
        asm volatile("s_waitcnt vmcnt(" #WAITN ") lgkmcnt(0)" ::: "memory"); __builtin_amdgcn_s_barrier(); asm volatile("" ::: "memory"); } while (0)
#define SCAN_LDD(dst, cc) asm volatile("global_load_dwordx4 %0, %1, off" : "=v"(dst) : "v"(dp + (size_t)(cc) * 4 * 128) : "memory")
        f32x4 dA, dB, dC;
        SCAN_DMA(0, 0); SCAN_LDD(dA, 0); SCAN_DMA(1, 1); SCAN_LDD(dB, 1);
        asm volatile("s_waitcnt vmcnt(0) lgkmcnt(0)" ::: "memory"); __builtin_amdgcn_s_barrier(); asm volatile("" ::: "memory");
        for (int c = 0; c < 60; c += 3) {
            SCAN_DMA(c + 2, 2); SCAN_LDD(dC, c + 2); SCAN_STEP(c, 0, dA, 8);
            SCAN_DMA(c + 3, 0); SCAN_LDD(dA, c + 3); SCAN_STEP(c + 1, 1, dB, 8);
            SCAN_DMA(c + 4, 1); SCAN_LDD(dB, c + 4); SCAN_STEP(c + 2, 2, dC, 8);
        }
        SCAN_DMA(62, 2); SCAN_LDD(dC, 62); SCAN_STEP(60, 0, dA, 0);
        SCAN_DMA(63, 0); SCAN_LDD(dA, 63); SCAN_STEP(61, 1, dB, 0);
        SCAN_STEP(62, 2, dC, 0);
        SCAN_STEP(63, 0, dA, 0);
#undef SCAN_DMA
#undef SCAN_STEP
#undef SCAN_LDD
        asm volatile("s_waitcnt vmcnt(0)" ::: "memory"); __syncthreads();
    }
}

__device__ __forceinline__ void attn_softmax_blk(f32x16& p0, f32x16& p1, f32x16& O0, f32x16& O1, float& mrun, float& lsum, bf16x8 (&pf)[4]) {
    const float PINF = __builtin_inff();
    float m0 = __builtin_amdgcn_fmed3f(p0[0], p1[0], PINF), m1 = __builtin_amdgcn_fmed3f(p0[1], p1[1], PINF), m2 = __builtin_amdgcn_fmed3f(p0[2], p1[2], PINF), m3 = __builtin_amdgcn_fmed3f(p0[3], p1[3], PINF);
#pragma unroll
    for (int r = 4; r < 16; r += 4) {
        m0 = __builtin_amdgcn_fmed3f(m0, p0[r], PINF); m1 = __builtin_amdgcn_fmed3f(m1, p0[r + 1], PINF); m2 = __builtin_amdgcn_fmed3f(m2, p0[r + 2], PINF); m3 = __builtin_amdgcn_fmed3f(m3, p0[r + 3], PINF);
        m0 = __builtin_amdgcn_fmed3f(m0, p1[r], PINF); m1 = __builtin_amdgcn_fmed3f(m1, p1[r + 1], PINF); m2 = __builtin_amdgcn_fmed3f(m2, p1[r + 2], PINF); m3 = __builtin_amdgcn_fmed3f(m3, p1[r + 3], PINF); }
    float mx = __builtin_amdgcn_fmed3f(__builtin_amdgcn_fmed3f(m0, m1, PINF), __builtin_amdgcn_fmed3f(m2, m3, PINF), PINF);
    mx = __builtin_amdgcn_fmed3f(mx, __shfl_xor(mx, 32), PINF);
    if (__builtin_amdgcn_ballot_w64(mx - mrun > 8.0f) != 0ull) {
        const float mnew = __builtin_amdgcn_fmed3f(mrun, mx, PINF); const float alpha = fast_exp2(mrun - mnew); lsum *= alpha;
#pragma unroll
        for (int r = 0; r < 16; ++r) { O0[r] *= alpha; O1[r] *= alpha; }
        mrun = mnew; }
    const f32x2 mm = (f32x2){mrun, mrun}; f32x2 ps2 = (f32x2){0.f, 0.f};
#pragma unroll
    for (int r = 0; r < 16; r += 2) {
        f32x2 a = (f32x2){p0[r], p0[r + 1]} - mm, b = (f32x2){p1[r], p1[r + 1]} - mm;
        a.x = fast_exp2(a.x); a.y = fast_exp2(a.y); b.x = fast_exp2(b.x); b.y = fast_exp2(b.y);
        p0[r] = a.x; p0[r + 1] = a.y; p1[r] = b.x; p1[r + 1] = b.y; ps2 += a; ps2 += b; }
    lsum += ps2.x + ps2.y;
    u32x4 w;
    w = (u32x4){pk2(p0[0], p0[1]), pk2(p0[2], p0[3]), pk2(p0[4], p0[5]), pk2(p0[6], p0[7])}; pf[0] = __builtin_bit_cast(bf16x8, w);
    w = (u32x4){pk2(p0[8], p0[9]), pk2(p0[10], p0[11]), pk2(p0[12], p0[13]), pk2(p0[14], p0[15])}; pf[1] = __builtin_bit_cast(bf16x8, w);
    w = (u32x4){pk2(p1[0], p1[1]), pk2(p1[2], p1[3]), pk2(p1[4], p1[5]), pk2(p1[6], p1[7])}; pf[2] = __builtin_bit_cast(bf16x8, w);
    w = (u32x4){pk2(p1[8], p1[9]), pk2(p1[10], p1[11]), pk2(p1[12], p1[13]), pk2(p1[14], p1[15])}; pf[3] = __builtin_bit_cast(bf16x8, w);
}
__device__ __forceinline__ void attn_bias_init(f32x16& p0, f32x16& p1, const LAS float* bt, bool table, float bconst) {
    if (table) {
#pragma unroll
        for (int g = 0; g < 4; ++g) { const f32x4 a = *(const LAS f32x4*)(bt + 8 * g), bq = *(const LAS f32x4*)(bt + 8 * g + 32);
#pragma unroll
            for (int i = 0; i < 4; ++i) { p0[4 * g + i] = a[i]; p1[4 * g + i] = bq[i]; } } }
    else {
#pragma unroll
        for (int r = 0; r < 16; ++r) { p0[r] = bconst; p1[r] = bconst; } }
}
__device__ __forceinline__ void attn_stage_yb(LAS unsigned char* yt, const f32x16& O0, const f32x16& O1, float inv, int row, int hi) {
#pragma unroll
    for (int d0 = 0; d0 < 2; ++d0)
#pragma unroll
        for (int g = 0; g < 4; ++g) { const int col = 32 * d0 + 8 * g + 4 * hi; float v[4];
#pragma unroll
            for (int i = 0; i < 4; ++i) v[i] = (d0 ? O1[4 * g + i] : O0[4 * g + i]) * inv;
            *(LAS u32x2*)(yt + row * 144 + col * 2) = (u32x2){pk2(v[0], v[1]), pk2(v[2], v[3])}; }
}
__device__ __forceinline__ void attn_merge_rows(const LAS unsigned char* yt, const LAS float* rsr, size_t tok0, int h, int lane, const bf16_t* OG, const bf16_t* RG, const bf16_t* GA, const bf16_t* GBt,
                                                const float* __restrict__ gla_norm, bf16_t* H) {
    const int c8 = lane & 7, col = h * 64 + 8 * c8;
    const f32x4 gn0 = *(const f32x4*)(gla_norm + (col & 255)), gn1 = *(const f32x4*)(gla_norm + (col & 255) + 4);
    u32x4 ogv[8], rgv[8], gav[8];
#pragma unroll
    for (int i = 0; i < 8; ++i) { const size_t o = (tok0 + 8 * i + (lane >> 3)) * D + col;
        ogv[i] = __builtin_nontemporal_load((const u32x4*)(OG + o)); rgv[i] = __builtin_nontemporal_load((const u32x4*)(RG + o)); gav[i] = __builtin_nontemporal_load((const u32x4*)((const char*)GA + 2 * o)); }
#pragma unroll
    for (int i = 0; i < 8; ++i) { const int row = 8 * i + (lane >> 3); const size_t o = (tok0 + row) * D + col;
        const u32x4 og = ogv[i], rg = rgv[i], ga = gav[i];
        const u32x4 yb = *(const LAS u32x4*)(yt + row * 144 + c8 * 16); const float rstdg = rsr[row];
        unsigned w[4];
#pragma unroll
        for (int q = 0; q < 4; ++q) { const float g0 = q < 2 ? gn0[2 * q] : gn1[2 * q - 4], g1 = q < 2 ? gn0[2 * q + 1] : gn1[2 * q - 3];
            float hv[2];
#pragma unroll
            for (int e = 0; e < 2; ++e) { const float r = e ? bf_hi(rg[q]) : bf_lo(rg[q]);
                const float sa = (float)((ga[q >> 1] >> (8 * (2 * (q & 1) + e))) & 255u), sb = (float)((ga[2 + (q >> 1)] >> (8 * (2 * (q & 1) + e))) & 255u);
                const float ogx = e ? bf_hi(og[q]) : bf_lo(og[q]), ybx = e ? bf_hi(yb[q]) : bf_lo(yb[q]), gnx = e ? g1 : g0;
                const float er = 1.0f + fast_exp2(__builtin_amdgcn_fmed3f(-LOG2E * r, -40.f, 40.f));
                hv[e] = (sa * (ogx * rstdg * gnx * r) * fast_rcp(er) + sb * ybx) * (1.0f / 255.0f); }
            w[q] = pk2(hv[0], hv[1]); }
        *(u32x4*)(H + o) = (u32x4){w[0], w[1], w[2], w[3]}; }
}
__device__ __forceinline__ void attn_phase(LAS unsigned char* lds, const bf16_t* QA, const bf16_t* KA, const bf16_t* VAT, const bf16_t* OG, const bf16_t* RG, const bf16_t* GA, const bf16_t* GBt,
                                           const float* OGSS, const float* __restrict__ gla_norm, const float* __restrict__ rel_bias, bf16_t* H, int G, int vcu, int tid, int variant) {
    const int lane = tid & 63, wid = __builtin_amdgcn_readfirstlane(tid >> 6), r32 = lane & 31, hi = lane >> 5;
    const int hh = wid & 3, cq = wid >> 2;
    LAS float* RTC = (LAS float*)(lds + ATT_BT_OFF);
    const int sw = (r32 >> 1) & 7;
    int rtc_hgp = -1;
    const int kvbase = hh * 8192 + r32 * 128;
    const int bsA = (63 - r32) & 3, bsB = (31 - r32) & 3;
    const int ybA = (hh * 4 + bsA) * 384 + (63 - r32 - bsA) + 4 * hi - 256;
    const int ybB = (hh * 4 + bsB) * 384 + (31 - r32 - bsB) + 4 * hi - 256;
    for (int u = vcu; u < NB * (NCH / 2) * 4; u += G) {
        const int b = u >> 7, c0 = 2 * ((u >> 2) & 31), hgp = u & 3, h = 4 * hgp + hh;
        const int tqA = b * TSEQ + (c0 + cq) * 64 + r32;
        if (hgp != rtc_hgp) {
            float tv[12];
#pragma unroll
            for (int q = 0; q < 12; ++q) { const int i = tid + 512 * q; const int hq = i / 1536, rem = i - hq * 1536, s = rem / 384, y = rem - s * 384; int d = 319 - (y + s); d = d > 256 ? 256 : d; tv[q] = rel_bias[(4 * hgp + hq) * 513 + d + 256]; }
#pragma unroll
            for (int q = 0; q < 12; ++q) RTC[tid + 512 * q] = LOG2E * tv[q];
            rtc_hgp = hgp; }
        const float bconst = LOG2E * rel_bias[h * 513 + 512];
        bf16x8 qfA[4], qfB[4];
#pragma unroll
        for (int d0 = 0; d0 < 4; ++d0) { qfA[d0] = __builtin_nontemporal_load((const bf16x8*)(QA + (size_t)tqA * D + h * 64 + 16 * d0 + 8 * hi)); qfB[d0] = __builtin_nontemporal_load((const bf16x8*)(QA + (size_t)(tqA + 32) * D + h * 64 + 16 * d0 + 8 * hi)); }
        const int smin = c0 >= 8 ? 0 : 8 - c0;
#define ATT_DMA(st, buf) do { const int tokk = b * TSEQ + (c0 - 8 + (st)) * 64; int ls_ = lane; asm volatile("" : "+v"(ls_));     \
        const char* kb_ = (const char*)(KA + (size_t)tokk * D + h * 64); const char* vb_ = (const char*)(VAT + ((size_t)(tokk >> 6) * 2048 + 1024 + h * 64) * 64); \
        _Pragma("unroll") for (int i = 0; i < 4; ++i) { const int row = 8 * (4 * cq + i) + (ls_ >> 3); const int gch = (ls_ & 7) ^ ((row >> 1) & 7); \
            __builtin_amdgcn_global_load_lds((const unsigned*)(kb_ + (unsigned)(row * (D * 2) + gch * 16)), (LAS unsigned*)(lds + (buf) * 65536 + hh * 8192 + (4 * cq + i) * 1024), 16, 0, 0); \
            __builtin_amdgcn_global_load_lds((const unsigned*)(vb_ + (unsigned)(row * 128 + gch * 16)), (LAS unsigned*)(lds + (buf) * 65536 + 32768 + hh * 8192 + (4 * cq + i) * 1024), 16, 0, 0); } } while (0)
        ATT_DMA(smin, smin & 1);
        f32x16 OA0, OA1, OB0, OB1;
#pragma unroll
        for (int r = 0; r < 16; ++r) { OA0[r] = 0.f; OA1[r] = 0.f; OB0[r] = 0.f; OB1[r] = 0.f; }
        float mA = -INFINITY, lA = 0.f, mB = -INFINITY, lB = 0.f;
        asm volatile("s_waitcnt vmcnt(0)" ::: "memory");
        __syncthreads();
        for (int st = smin; st <= 9; ++st) {
            const int buf = st & 1;
            if (st < 9 && !(variant & 2)) ATT_DMA(st + 1, buf ^ 1);
            const int j = st - cq;
            if (j >= 0 && j <= 8 && !(variant & 1)) {
                const LAS unsigned char* tb = lds + buf * 65536 + kvbase;
                int swl = sw; asm volatile("" : "+v"(swl));
#define KADDR(d0) ((((2 * (d0) + hi) ^ swl) << 4))
#define VADDR(cc) (32768 + ((((cc) ^ swl) << 4)) + 8 * hi)
                f32x16 pA0, pA1, pB0, pB1;
                attn_bias_init(pA0, pA1, RTC + ybA + 64 * j, j >= 4, bconst);
                attn_bias_init(pB0, pB1, RTC + ybB + 64 * j, j >= 4, bconst);
#pragma unroll
                for (int dh = 0; dh < 2; ++dh) { bf16x8 kf[2][2];
#pragma unroll
                    for (int x = 0; x < 2; ++x) { kf[x][0] = *(const LAS bf16x8*)(tb + KADDR(2 * dh + x)); kf[x][1] = *(const LAS bf16x8*)(tb + KADDR(2 * dh + x) + 4096); }
                    __builtin_amdgcn_sched_barrier(0);
#pragma unroll
                    for (int x = 0; x < 2; ++x) { pA0 = MFMA32(kf[x][0], qfA[2 * dh + x], pA0); pA1 = MFMA32(kf[x][1], qfA[2 * dh + x], pA1); }
                    __builtin_amdgcn_sched_barrier(0); }
                __builtin_amdgcn_sched_barrier(0);
                bf16x8 pfA[4], pfB[4];
#pragma unroll
                for (int d0 = 0; d0 < 4; ++d0) { const bf16x8 k0 = *(const LAS bf16x8*)(tb + KADDR(d0)), k1 = *(const LAS bf16x8*)(tb + KADDR(d0) + 4096);
                    pB0 = MFMA32(k0, qfB[d0], pB0); pB1 = MFMA32(k1, qfB[d0], pB1); }
                attn_softmax_blk(pA0, pA1, OA0, OA1, mA, lA, pfA);
#pragma unroll
                for (int q = 0; q < 8; ++q) { __builtin_amdgcn_sched_group_barrier(0x8, 1, 0); __builtin_amdgcn_sched_group_barrier(0x2, 14, 0); __builtin_amdgcn_sched_group_barrier(0x400, 4, 0); }
                __builtin_amdgcn_sched_barrier(0);
#pragma unroll
                for (int s = 0; s < 4; ++s) {
                    const s16x4 a0l = *(const LAS s16x4*)(tb + VADDR(2 * s)), a0h = *(const LAS s16x4*)(tb + VADDR(2 * s + 1));
                    const s16x4 a1l = *(const LAS s16x4*)(tb + VADDR(2 * s) + 4096), a1h = *(const LAS s16x4*)(tb + VADDR(2 * s + 1) + 4096);
                    const bf16x8 a0 = __builtin_shufflevector(a0l, a0h, 0, 1, 2, 3, 4, 5, 6, 7), a1 = __builtin_shufflevector(a1l, a1h, 0, 1, 2, 3, 4, 5, 6, 7);
                    OA0 = MFMA32(a0, pfA[s], OA0); OA1 = MFMA32(a1, pfA[s], OA1); }
                attn_softmax_blk(pB0, pB1, OB0, OB1, mB, lB, pfB);
#pragma unroll
                for (int q = 0; q < 8; ++q) { __builtin_amdgcn_sched_group_barrier(0x8, 1, 0); __builtin_amdgcn_sched_group_barrier(0x2, 14, 0); __builtin_amdgcn_sched_group_barrier(0x400, 4, 0); }
                __builtin_amdgcn_sched_barrier(0);
#pragma unroll
                for (int s = 0; s < 4; ++s) {
                    const s16x4 a0l = *(const LAS s16x4*)(tb + VADDR(2 * s)), a0h = *(const LAS s16x4*)(tb + VADDR(2 * s + 1));
                    const s16x4 a1l = *(const LAS s16x4*)(tb + VADDR(2 * s) + 4096), a1h = *(const LAS s16x4*)(tb + VADDR(2 * s + 1) + 4096);
                    const bf16x8 a0 = __builtin_shufflevector(a0l, a0h, 0, 1, 2, 3, 4, 5, 6, 7), a1 = __builtin_shufflevector(a1l, a1h, 0, 1, 2, 3, 4, 5, 6, 7);
                    OB0 = MFMA32(a0, pfB[s], OB0); OB1 = MFMA32(a1, pfB[s], OB1); }
            }
            asm volatile("s_waitcnt vmcnt(0)" ::: "memory");
            __syncthreads();
        }
#undef ATT_DMA
#undef KADDR
#undef VADDR
        lA += __shfl_xor(lA, 32); lB += __shfl_xor(lB, 32);
        if (!(variant & 4)) {
            int le = lane; asm volatile("" : "+v"(le));
            const int r32e = le & 31, hie = le >> 5;
            LAS unsigned char* yt = lds + wid * 16384; LAS float* rsr = (LAS float*)(yt + 9216);
            const size_t tok0 = (size_t)b * TSEQ + (c0 + cq) * 64;
            { float ss = 0.f; const f32x4* sp = (const f32x4*)(OGSS + ((tok0 + le) * 4 + hgp) * 16);
#pragma unroll
              for (int k = 0; k < 4; ++k) { const f32x4 v = sp[k]; ss += (v.x + v.y) + (v.z + v.w); }
              rsr[le] = 1.0f / sqrtf(ss * (1.0f / 256.0f) + EPS); }
            attn_stage_yb(yt, OA0, OA1, 1.0f / lA, r32e, hie);
            attn_stage_yb(yt, OB0, OB1, 1.0f / lB, 32 + r32e, hie);
            asm volatile("s_waitcnt lgkmcnt(0)" ::: "memory");
            attn_merge_rows(yt, rsr, tok0, h, le, OG, RG, GA, GBt, gla_norm, H);
        }
        asm volatile("s_waitcnt lgkmcnt(0)" ::: "memory"); __builtin_amdgcn_s_barrier(); asm volatile("" ::: "memory");
    }
}
__device__ __forceinline__ void router_phase(LAS unsigned char* lds, const bf16_t* x1, const bf16_t* WRH, const bf16_t* WRL, const float* __restrict__ b_router,
                                             int* TOPI, float* TOPW, float* RSTD1, int* CNT, int G, int bid, int tid) {
    const int lane = tid & 63, wid = __builtin_amdgcn_readfirstlane(tid >> 6), l15 = lane & 15, lq = lane >> 4;
    LAS float* LG = (LAS float*)lds;
    LAS float* RS = (LAS float*)(lds + 128 * 33 * 4);
    LAS int* HIST = (LAS int*)(lds + 128 * 33 * 4 + 512);
    constexpr int WPITCH = 2064; LAS unsigned char* WH = lds + 18432; LAS unsigned char* WL = WH + 32 * WPITCH;
    for (int i = tid; i < 32 * 128; i += 512) { const int e = i >> 7, ch = i & 127;
        *(LAS u32x4*)(WH + e * WPITCH + ch * 16) = *(const u32x4*)(WRH + (size_t)e * D + ch * 8); *(LAS u32x4*)(WL + e * WPITCH + ch * 16) = *(const u32x4*)(WRL + (size_t)e * D + ch * 8); }
    __syncthreads();
    for (int tix = bid; tix < NTOK / 128; tix += G) {
        if (tid < 32) HIST[tid] = 0;
        const int tok = tix * 128 + 16 * wid + l15;
        const bf16_t* xr = x1 + (size_t)tok * D + 8 * lq;
        f32x4 acc0 = (f32x4){0.f, 0.f, 0.f, 0.f}, acc1 = (f32x4){0.f, 0.f, 0.f, 0.f}; float ss = 0.f;
#pragma unroll 1
        for (int kb = 0; kb < 32; kb += 8) {
            u32x4 xa[8];
#pragma unroll
            for (int q = 0; q < 8; ++q) xa[q] = *(const u32x4*)(xr + 32 * (kb + q));
#pragma unroll
            for (int q = 0; q < 8; ++q) { const int ks = kb + q; const u32x4 a = xa[q];
#pragma unroll
                for (int j = 0; j < 4; ++j) { const float lo = bf_lo(a[j]), hi = bf_hi(a[j]); ss += lo * lo + hi * hi; }
                const bf16x8 ax = __builtin_bit_cast(bf16x8, a);
                const int wo = (32 * ks + 8 * lq) * 2;
                const bf16x8 bh0 = *(const LAS bf16x8*)(WH + l15 * WPITCH + wo), bh1 = *(const LAS bf16x8*)(WH + (16 + l15) * WPITCH + wo);
                const bf16x8 bl0 = *(const LAS bf16x8*)(WL + l15 * WPITCH + wo), bl1 = *(const LAS bf16x8*)(WL + (16 + l15) * WPITCH + wo);
                acc0 = MFMA16(ax, bh0, acc0); acc0 = MFMA16(ax, bl0, acc0);
                acc1 = MFMA16(ax, bh1, acc1); acc1 = MFMA16(ax, bl1, acc1); }
        }
        ss += __shfl_xor(ss, 16); ss += __shfl_xor(ss, 32);
        const float rstd = 1.0f / sqrtf(ss * (1.f / D) + EPS);
        if (lq == 0) { RS[16 * wid + l15] = rstd; RSTD1[tok] = rstd; }
        __syncthreads();
#pragma unroll
        for (int i = 0; i < 4; ++i) { const int tl = 16 * wid + 4 * lq + i; const float r = RS[tl];
            LG[tl * 33 + l15] = acc0[i] * r + b_router[l15]; LG[tl * 33 + 16 + l15] = acc1[i] * r + b_router[16 + l15]; }
        __syncthreads();
        if (tid < 128) {
            const LAS float* lg = LG + tid * 33; float v[4]; int id[4];
#pragma unroll
            for (int k = 0; k < 4; ++k) { float bv = -INFINITY; int bi = 0;
                for (int e = 0; e < NEXP; ++e) { const float x = lg[e]; bool taken = false;
#pragma unroll
                    for (int q = 0; q < 4; ++q) if (q < k && id[q] == e) taken = true;
                    if (!taken && x > bv) { bv = x; bi = e; } }
                v[k] = bv; id[k] = bi; }
            const float e1 = __expf(v[1] - v[0]), e2 = __expf(v[2] - v[0]), e3 = __expf(v[3] - v[0]); const float inv = 1.0f / (1.0f + e1 + e2 + e3);
            const int t = tix * 128 + tid;
            *(int4*)(TOPI + (size_t)t * 4) = make_int4(id[0], id[1], id[2], id[3]);
            *(f32x4*)(TOPW + (size_t)t * 4) = (f32x4){inv, e1 * inv, e2 * inv, e3 * inv};
#pragma unroll
            for (int k = 0; k < 4; ++k) __hip_atomic_fetch_add(&HIST[id[k]], 1, __ATOMIC_RELAXED, __HIP_MEMORY_SCOPE_WORKGROUP);
        }
        __syncthreads();
        if (tid < 32) CNT[tix * 32 + tid] = HIST[tid];
        __syncthreads();
    }
}

__device__ __forceinline__ void assign_phase(LAS unsigned char* lds, const int* TOPI, const float* TOPW, const float* RSTD1, const int* CNT,
                                             int* TOKSLOT, float* GATESLOT, float* RSTDSLOT, int* SLOTTOK, int* TILEEXP, int* NTILES, int G, int bid, int tid) {
    LAS int* PART = (LAS int*)lds;
    LAS int* PARTB = PART + 512;
    LAS int* TOT = PART + 1024;
    LAS int* BEF = PART + 1056;
    LAS int* BASE = PART + 1088;
    LAS int* IDS = PART + 1120;
    LAS int* WC = PART + 1632;
    constexpr int NTILE = NTOK / 128;
    for (int tix = bid; tix < NTILE; tix += G) {
        { const int e = tid & 31, part = tid >> 5; int s = 0, sb = 0;
          int cv[16];
#pragma unroll
          for (int q = 0; q < 16; ++q) cv[q] = CNT[(part * 16 + q) * 32 + e];
#pragma unroll
          for (int q = 0; q < 16; ++q) { s += cv[q]; if (part * 16 + q < tix) sb += cv[q]; }
          PART[part * 32 + e] = s; PARTB[part * 32 + e] = sb; }
        IDS[tid] = TOPI[(size_t)tix * 512 + tid];
        const float my_w = TOPW[(size_t)tix * 512 + tid], my_rs = RSTD1[tix * 128 + (tid >> 2)];
        __syncthreads();
        if (tid < 32) { int s = 0, sb = 0;
            for (int p = 0; p < 16; ++p) { s += PART[p * 32 + tid]; sb += PARTB[p * 32 + tid]; }
            TOT[tid] = s; BEF[tid] = sb; }
        __syncthreads();
        if (tid < 32) { int base = 0; for (int e = 0; e < tid; ++e) base += (TOT[e] + 255) & ~255; BASE[tid] = base; }
        __syncthreads();
        {
            const int lane = tid & 63, w = tid >> 6; const int id = IDS[tid]; int rank = 0, cnt = 0;
            for (int e = 0; e < NEXP; ++e) { const unsigned long long mask = __ballot(id == e); if (lane == e) cnt = __popcll(mask); if (id == e) rank = __popcll(mask & ((1ull << lane) - 1ull)); }
            if (lane < 32) WC[w * 32 + lane] = cnt;
            __syncthreads();
            int pre = 0;
            for (int q = 0; q < 8; ++q) if (q < w) pre += WC[q * 32 + id];
            const int slot = BASE[id] + BEF[id] + pre + rank; const int t = tix * 128 + (tid >> 2);
            TOKSLOT[slot] = t; GATESLOT[slot] = my_w; RSTDSLOT[slot] = my_rs; SLOTTOK[(size_t)tix * 512 + tid] = slot;
        }
        if (tid < 32) {
            LAS int* tel = (LAS int*)(lds + 131072 + 20480); const int e = tid, nt = (TOT[e] + 255) >> 8, tb = BASE[e] >> 8;
            for (int i = 0; i < nt; ++i) tel[tb + i] = e;
            if (e == 31) { tel[1022] = tb + nt; tel[1023] = 0x7e1; } }
        if (tix == 0) {
            if (tid < 32) { const int e = tid, nt = (TOT[e] + 255) >> 8, tb = BASE[e] >> 8;
                for (int i = 0; i < nt; ++i) TILEEXP[tb + i] = e;
                if (e == 31) NTILES[0] = tb + nt; }
            for (int e = 0; e < NEXP; ++e) { const int s0 = BASE[e] + TOT[e], s1 = BASE[e] + ((TOT[e] + 255) & ~255);
                for (int s = s0 + tid; s < s1; s += 512) { TOKSLOT[s] = 0; GATESLOT[s] = 0.f; RSTDSLOT[s] = 0.f; } }
        }
        __syncthreads();
    }
}

__device__ __forceinline__ void combine_row_load(const bf16_t* x1, const unsigned char* YS, const int4 sl, int m, int lane, f32x4 (&v)[4], unsigned (&yw)[4][4]) {
    const u32x2* xr = (const u32x2*)(x1 + (size_t)m * D) + lane;
    const int sls[4] = {sl.x, sl.y, sl.z, sl.w};
#pragma unroll
    for (int j = 0; j < 4; ++j) { const u32x2 w = __builtin_nontemporal_load(xr + 64 * j); v[j] = (f32x4){bf_lo(w.x), bf_hi(w.x), bf_lo(w.y), bf_hi(w.y)}; }
#pragma unroll
    for (int k = 0; k < 4; ++k) { const unsigned* yr = (const unsigned*)(YS + (size_t)sls[k] * D) + lane;
#pragma unroll
        for (int j = 0; j < 4; ++j) yw[k][j] = __builtin_nontemporal_load(yr + 64 * j); }
}
__device__ __forceinline__ void combine_row_finish(f32x4 (&v)[4], const unsigned (&yw)[4][4], bf16_t* X2B, unsigned char* XF8, float* RSTD2, int m, int lane) {
#pragma unroll
    for (int k = 0; k < 4; ++k)
#pragma unroll
        for (int j = 0; j < 4; ++j) { const unsigned w = yw[k][j]; f32x2 lo = __builtin_amdgcn_cvt_pk_f32_fp8((int)w, false), hi = __builtin_amdgcn_cvt_pk_f32_fp8((int)w, true);
            v[j].x += lo.x * (1.0f / YSCALE); v[j].y += lo.y * (1.0f / YSCALE); v[j].z += hi.x * (1.0f / YSCALE); v[j].w += hi.y * (1.0f / YSCALE); }
    float s = 0.f;
#pragma unroll
    for (int j = 0; j < 4; ++j) s += (v[j].x * v[j].x + v[j].y * v[j].y) + (v[j].z * v[j].z + v[j].w * v[j].w);
    s = wave_sum(s);
    u32x2* ob = (u32x2*)(X2B + (size_t)m * D) + lane; unsigned* o8 = (unsigned*)(XF8 + (size_t)m * D) + lane;
#pragma unroll
    for (int j = 0; j < 4; ++j) { ob[64 * j] = (u32x2){pk2(v[j].x, v[j].y), pk2(v[j].z, v[j].w)}; o8[64 * j] = pk4_fp8(v[j].x, v[j].y, v[j].z, v[j].w); }
    if (lane == 0) RSTD2[m] = 1.0f / sqrtf(s * (1.f / D) + EPS);
}
__device__ __forceinline__ void combine_phase(const bf16_t* x1, const unsigned char* YS, const int* SLOTTOK, bf16_t* X2B, unsigned char* XF8, float* RSTD2, int G, int vcu, int tid) {
    const int lane = tid & 63, wave = tid >> 6; const int gw = vcu * NWAVES + wave, NGW = G * NWAVES;
    int4 sa = make_int4(0, 0, 0, 0), sb = sa;
    if (gw < NTOK) { sa = *(const int4*)(SLOTTOK + (size_t)gw * 4); sb = *(const int4*)(SLOTTOK + (size_t)((gw + NGW < NTOK) ? gw + NGW : gw) * 4); }
    for (int m = gw; m < NTOK; m += 2 * NGW) {
        const int m2 = m + NGW; const bool has2 = m2 < NTOK;
        const int n1 = m + 2 * NGW, n2 = m + 3 * NGW; int4 na = sa, nb = sb;
        if (n1 < NTOK) { na = *(const int4*)(SLOTTOK + (size_t)n1 * 4); nb = *(const int4*)(SLOTTOK + (size_t)(n2 < NTOK ? n2 : n1) * 4); }
        f32x4 va[4], vb[4]; unsigned ya[4][4], yb[4][4];
        combine_row_load(x1, YS, sa, m, lane, va, ya);
        combine_row_load(x1, YS, sb, has2 ? m2 : m, lane, vb, yb);
        combine_row_finish(va, ya, X2B, XF8, RSTD2, m, lane);
        if (has2) combine_row_finish(vb, yb, X2B, XF8, RSTD2, m2, lane);
        sa = na; sb = nb;
    }
}

__device__ __forceinline__ void final_row_load(const bf16_t* X2B, const unsigned char* PP, const unsigned char* GATE, int m, int lane, u32x2 (&xw)[4], unsigned (&pw)[4], unsigned (&gw)[4]) {
    const u32x2* xr = (const u32x2*)(X2B + (size_t)m * D) + lane; const unsigned* pr = (const unsigned*)(PP + (size_t)m * D) + lane; const unsigned* gr = (const unsigned*)(GATE + (size_t)m * D) + lane;
#pragma unroll
    for (int j = 0; j < 4; ++j) { xw[j] = __builtin_nontemporal_load(xr + 64 * j); pw[j] = __builtin_nontemporal_load(pr + 64 * j); gw[j] = __builtin_nontemporal_load(gr + 64 * j); }
}
__device__ __forceinline__ void final_row_finish(float* out, const u32x2 (&xw)[4], const unsigned (&pw)[4], const unsigned (&gw)[4], const f32x4 (&gn)[4], int m, int lane) {
    f32x4 v[4]; float s = 0.f;
#pragma unroll
    for (int j = 0; j < 4; ++j) { const f32x2 p01 = __builtin_amdgcn_cvt_pk_f32_fp8((int)pw[j], false), p23 = __builtin_amdgcn_cvt_pk_f32_fp8((int)pw[j], true); const unsigned g = gw[j];
        const float sc = 1.0f / (255.0f * PSCALE);
        v[j] = (f32x4){bf_lo(xw[j].x) + (float)(g & 255u) * p01[0] * sc, bf_hi(xw[j].x) + (float)((g >> 8) & 255u) * p01[1] * sc, bf_lo(xw[j].y) + (float)((g >> 16) & 255u) * p23[0] * sc, bf_hi(xw[j].y) + (float)(g >> 24) * p23[1] * sc};
        s += (v[j].x * v[j].x + v[j].y * v[j].y) + (v[j].z * v[j].z + v[j].w * v[j].w); }
    s = wave_sum(s);
    const float rstd = 1.0f / sqrtf(s * (1.f / D) + EPS);
    f32x4* orow = (f32x4*)(out + (size_t)m * D) + lane;
#pragma unroll
    for (int j = 0; j < 4; ++j) __builtin_nontemporal_store(v[j] * rstd * gn[j], orow + 64 * j);
}
__device__ __forceinline__ void final_phase(float* out, const bf16_t* X2B, const unsigned char* PP, const unsigned char* GATE, const float* __restrict__ ln_final, int G, int vcu, int tid) {
    const int lane = tid & 63, wave = tid >> 6; const int gw = vcu * NWAVES + wave, NGW = G * NWAVES;
    f32x4 gn[4];
#pragma unroll
    for (int j = 0; j < 4; ++j) gn[j] = *((const f32x4*)ln_final + lane + 64 * j);
    for (int m = gw; m < NTOK; m += 2 * NGW) {
        const int m2 = m + NGW; const bool has2 = m2 < NTOK;
        u32x2 xa[4], xb[4]; unsigned pa[4], pb[4], ga[4], gb[4];
        final_row_load(X2B, PP, GATE, m, lane, xa, pa, ga);
        final_row_load(X2B, PP, GATE, has2 ? m2 : m, lane, xb, pb, gb);
        final_row_finish(out, xa, pa, ga, gn, m, lane);
        if (has2) final_row_finish(out, xb, pb, gb, gn, m2, lane);
    }
}
#ifndef PROBE_VARIANT
#define PROBE_VARIANT 0
#endif
#ifndef MK_N_LAUNCHES
#define MK_N_LAUNCHES 1
#endif
constexpr int N_PHASES = 13;
struct Args { const float* in[20]; float* out; unsigned char* ws; int ph_lo, ph_hi, variant, pad; };
static_assert(sizeof(Args) == 20 * 8 + 8 + 8 + 16, "Args has no padding");

__global__ void __launch_bounds__(NWAVES * 64, 2) fwd_kernel(Args args) {
    extern __shared__ __attribute__((aligned(16))) unsigned char lds_raw[];
    LAS unsigned char* lds = (LAS unsigned char*)lds_raw;
    volatile LAS unsigned* MISC = (volatile LAS unsigned*)(lds + MISC_OFF);
    const int tid = threadIdx.x, G = gridDim.x, bid = blockIdx.x;
    const int vcu = (G % 8 == 0) ? (bid % 8) * (G / 8) + bid / 8 : bid;
    unsigned char* ws = args.ws;
    unsigned* ctl = (unsigned*)(ws + WS_CTL);
    for (int u = tid; u < (LDS_BYTES - MISC_OFF) / 4; u += NWAVES * 64) ((LAS unsigned*)(lds + MISC_OFF))[u] = 0u;
    __syncthreads();
#ifdef PROBE_PREFIX
    const int variant = args.variant;
#else
    constexpr int variant = 0;
#endif
    const int lo = args.ph_lo, hi = args.ph_hi;
    XcdBarrier bar; bar.bar = ctl + CW_BAR; bar.x = 0; bar.st = nullptr;
    if (hi - lo > 1) bar = xcd_barrier_post(ctl + CW_BAR, MISC + 8);
#define IN(k) (lo <= (k) && (k) < hi)
#ifdef REPEAT_PHASE
#define REPS(k) ((k) == REPEAT_PHASE ? 2 : 1)
#define REPVAR(k, rep) (((k) == REPEAT_PHASE && (rep) == 0) ? REPEAT_VARIANT : 0)
#else
#define REPS(k) 1
#define REPVAR(k, rep) variant
#endif
#define TIDP() ({ int t_ = tid; asm volatile("" : "+v"(t_)); t_; })
#define SEAM(k) do { if (IN(k) && IN((k) + 1)) xcd_barrier(bar); } while (0)
    const float* x = args.in[0]; float* out = args.out;
    bf16_t* WIN = (bf16_t*)(ws + WS_WIN);
    bf16_t* XN = (bf16_t*)(ws + WS_XN); bf16_t* OG = (bf16_t*)(ws + WS_OG);
    bf16_t* Z512 = (bf16_t*)(ws + WS_Z512); bf16_t* Z1024 = (bf16_t*)(ws + WS_Z1024);
    bf16_t* QG = Z512; bf16_t* KG = Z512 + (size_t)NTOK * 512; bf16_t* UG = Z512 + (size_t)2 * NTOK * 512;
    bf16_t* RG = Z1024; bf16_t* QA = Z1024 + (size_t)NTOK * D; bf16_t* KA = Z1024 + (size_t)2 * NTOK * D; bf16_t* GA = Z1024 + (size_t)3 * NTOK * D; bf16_t* GBt = Z1024 + (size_t)4 * NTOK * D;
    bf16_t* VT = (bf16_t*)(ws + WS_VT);
    bf16_t* KTT = (bf16_t*)(ws + WS_KTT); float* OGSS = (float*)(ws + WS_OGSS); float* DL = (float*)(ws + WS_DL);
    bf16_t* Hm = (bf16_t*)(ws + WS_H); unsigned char* X1B = ws + WS_X1B;     bf16_t* PP = (bf16_t*)(ws + WS_PP);
    unsigned char* ACT = ws + WS_ACT;     unsigned char* YS = ws + WS_YS;     bf16_t* X2B = (bf16_t*)(ws + WS_X2B);
    unsigned char* rt = ws + WS_RT;
    int* TOPI = (int*)(rt + RT_TOPI); float* TOPW = (float*)(rt + RT_TOPW); float* RSTD1 = (float*)(rt + RT_RSTD1); int* CNT = (int*)(rt + RT_CNT);
    int* TOKSLOT = (int*)(rt + RT_TOKSLOT); float* GATESLOT = (float*)(rt + RT_GATESLOT); float* RSTDSLOT = (float*)(rt + RT_RSTDSLOT); int* SLOTTOK = (int*)(rt + RT_SLOTTOK);
    int* TILEEXP = (int*)(rt + RT_TILEEXP); int* NTILES = (int*)(rt + RT_NTILES); float* RSTD2 = (float*)(rt + RT_RSTD2);
    float* SSP = (float*)(ws + WS_SSP);

    if (IN(0)) for (int rep = 0; rep < REPS(0); ++rep) {
        P0Args a; a.x = x; a.p = args.in[1]; a.ln_mix = args.in[2]; a.w_in = args.in[3]; a.w_gk = args.in[4]; a.w_out = args.in[8]; a.ln_moe = args.in[9]; a.w_router = args.in[10];
        a.w1 = args.in[12]; a.b1 = args.in[13]; a.w2 = args.in[14]; a.ln_ple = args.in[16]; a.w_pg = args.in[17]; a.w_pp = args.in[18]; a.ws = ws;
        p0_prologue(a, lds, TIDP(), G, vcu);
        if (rep + 1 < REPS(0)) xcd_barrier(bar);
    }
    SEAM(0);
    if (IN(1)) for (int rep = 0; rep < REPS(1); ++rep) {
        const bf16_t* XN8 = (const bf16_t*)(ws + WS_XN8); const bf16_t* WIN8 = (const bf16_t*)(ws + WS_WIN8);
        { pg8::Gemm g{XN, WIN, D}; pg8::StaticOrder S; S.init(NTOK, 2048, G, bid); EpiZ<0> E{Z512, Z1024, -1}; pg8::gemm_phase(lds, g, S, E, variant); }
        { pg8::Gemm g{XN8, WIN8, D / 2}; pg8::StaticOrder S; S.init(NTOK, 2048, G, bid); EpiZ<1> E{Z512, Z1024, -1}; pg8::gemm_phase<EpiZ<1>, pg8::StaticOrder, true>(lds, g, S, E); }
        { pg8::Gemm g{XN8, WIN8 + (size_t)2048 * (D / 2), D / 2}; pg8::StaticOrder S; S.init(NTOK, 2048, G, bid); EpiG E{(unsigned char*)GA}; pg8::gemm_phase<EpiG, pg8::StaticOrder, true>(lds, g, S, E); }
        { pg8::Gemm g{WIN8 + (size_t)4096 * (D / 2), XN8, D / 2}; pg8::StaticOrder S; S.init(2048, NTOK, G, bid); EpiVT E{VT, 0, 1.0f / WSCALE}; pg8::gemm_phase<EpiVT, pg8::StaticOrder, true>(lds, g, S, E); }
        { pg8::Gemm g{(const bf16_t*)(ws + WS_PB), (const bf16_t*)(ws + WS_WPP), 256}; pg8::StaticOrder S; S.init(NTOK, D, G, bid); EpiB E{(unsigned char*)PP, D, PSCALE}; pg8::gemm_phase(lds, g, S, E); }
        if (rep + 1 < REPS(1)) xcd_barrier(bar);
    }
    SEAM(1);
    if (IN(2)) gla_pre(lds, QG, KG, (const float*)(ws + WS_GKL), args.in[4], args.in[5], KTT, DL, (bf16_t*)(ws + WS_AT), G, bid, TIDP());
    SEAM(2);
    if (IN(3)) gla_scan(lds, QG, KTT, VT, (const bf16_t*)(ws + WS_AT), DL, OG, OGSS, G, vcu, TIDP(), variant);
    SEAM(3);
    if (IN(4)) for (int rep = 0; rep < REPS(4); ++rep) { if (rep) xcd_barrier(bar); attn_phase(lds, QA, KA, VT, OG, RG, GA, GBt, OGSS, args.in[6], args.in[7], Hm, G, vcu, TIDP(), REPVAR(4, rep)); }
    SEAM(4);
    if (IN(5)) for (int rep = 0; rep < REPS(5); ++rep) { if (rep) xcd_barrier(bar); pg8::Gemm g{Hm, (const bf16_t*)(ws + WS_WOUT), D}; pg8::StaticOrder S; S.init(NTOK, D, G, bid); EpiX1 E{x, X2B, X1B}; pg8::gemm_phase(lds, g, S, E); }
    SEAM(5);
    if (IN(6)) for (int rep = 0; rep < REPS(6); ++rep) { if (rep) xcd_barrier(bar); router_phase(lds, X2B, (const bf16_t*)(ws + WS_WRH), (const bf16_t*)(ws + WS_WRL), args.in[11], TOPI, TOPW, RSTD1, CNT, G, bid, TIDP()); }
    SEAM(6);
    if (IN(7)) for (int rep = 0; rep < REPS(7); ++rep) { if (rep) xcd_barrier(bar); assign_phase(lds, TOPI, TOPW, RSTD1, CNT, TOKSLOT, GATESLOT, RSTDSLOT, SLOTTOK, TILEEXP, NTILES, G, bid, TIDP()); }
    SEAM(7);
    LAS int* const TEL = (LAS int*)(lds + 131072 + 20480);
#define MOE_TABLE() int ntiles; if (TEL[1023] == 0x7e1) ntiles = __builtin_amdgcn_readfirstlane(TEL[1022]); \
        else { ntiles = __builtin_amdgcn_readfirstlane(NTILES[0]); __syncthreads(); for (int i = tid; i < ntiles; i += NWAVES * 64) TEL[i] = TILEEXP[i]; __syncthreads(); }
    if (IN(8)) { MOE_TABLE();
        for (int rep = 0; rep < REPS(8); ++rep) {
        pg8::Gemm g{(const bf16_t*)X1B, (const bf16_t*)(ws + WS_W1), D / 2}; pg8::MoeOrder<true> S{TEL, TOKSLOT, ntiles, 8, G, bid}; EpiSwiglu E{RSTDSLOT, (const float*)(ws + WS_B1P), ACT}; pg8::gemm_phase<EpiSwiglu, pg8::MoeOrder<true>, true>(lds, g, S, E, REPVAR(8, rep));
        if (rep + 1 < REPS(8)) xcd_barrier(bar); } }
    SEAM(8);
    if (IN(9)) { MOE_TABLE();
        for (int rep = 0; rep < REPS(9); ++rep) {
        pg8::Gemm g{(const bf16_t*)ACT, (const bf16_t*)(ws + WS_W2), D / 2}; pg8::MoeOrder<false> S{TEL, TOKSLOT, ntiles, 4, G, bid}; EpiY E{GATESLOT, args.in[15], YS, lds + 131072}; pg8::gemm_phase<EpiY, pg8::MoeOrder<false>, true>(lds, g, S, E, REPVAR(9, rep));
        if (rep + 1 < REPS(9)) xcd_barrier(bar); } }
    SEAM(9);
    if (IN(10)) for (int rep = 0; rep < REPS(10); ++rep) { if (rep) xcd_barrier(bar); combine_phase(X2B, YS, SLOTTOK, X2B, X1B, RSTD2, G, vcu, TIDP()); }
    SEAM(10);
    if (IN(11)) { pg8::Gemm g{(const bf16_t*)X1B, (const bf16_t*)(ws + WS_WPG), D / 2}; pg8::StaticOrder S; S.init(NTOK, D, G, bid); EpiPle E{RSTD2, ws + WS_AT}; pg8::gemm_phase<EpiPle, pg8::StaticOrder, true>(lds, g, S, E); }
    SEAM(11);
    if (IN(12)) final_phase(out, X2B, (const unsigned char*)PP, ws + WS_AT, args.in[19], G, vcu, TIDP());
#undef IN
#undef SEAM
}

extern "C" void kernel_launch(void* const* d_in, const int* in_sizes, int n_in, void* d_out, int out_size, void* d_ws, size_t ws_size, hipStream_t stream) {
    static int grid = 0;
    if (grid == 0) {
        if (n_in != 20 || out_size != NTOK * D || ws_size < WS_END) { fprintf(stderr, "kernel_launch: unexpected shapes (n_in %d out %d ws %zu)\n", n_in, out_size, ws_size); grid = -1; return; }
        int dev = 0, cus = 0, per_cu = 0;
        if (hipGetDevice(&dev) != hipSuccess || hipDeviceGetAttribute(&cus, hipDeviceAttributeMultiprocessorCount, dev) != hipSuccess) { grid = -1; return; }
        if (hipFuncSetAttribute((const void*)fwd_kernel, hipFuncAttributeMaxDynamicSharedMemorySize, LDS_BYTES) != hipSuccess) { fprintf(stderr, "kernel_launch: hipFuncSetAttribute failed\n"); grid = -1; return; }
        if (hipOccupancyMaxActiveBlocksPerMultiprocessor(&per_cu, (const void*)fwd_kernel, NWAVES * 64, LDS_BYTES) != hipSuccess || per_cu < 1) { fprintf(stderr, "kernel_launch: occupancy query says %d\n", per_cu); }
        (void)hipGetLastError();
        grid = cus;
    }
    if (grid < 0) return;
    (void)hipMemsetAsync((char*)d_ws + WS_CTL, 0, CTL_ZERO_BYTES, stream);
    Args a{};
    for (int i = 0; i < 20; ++i) a.in[i] = (const float*)d_in[i];
    a.out = (float*)d_out; a.ws = (unsigned char*)d_ws;
#ifdef PROBE_PREFIX
    for (int p = 0; p < PROBE_PREFIX; ++p) { a.ph_lo = p; a.ph_hi = p + 1; a.variant = (p == PROBE_PREFIX - 1) ? PROBE_VARIANT : 0; hipLaunchKernelGGL(fwd_kernel, dim3(grid), dim3(NWAVES * 64), LDS_BYTES, stream, a); }
    a.variant = 0;
#endif
#if MK_N_LAUNCHES == 1
    a.ph_lo = 0; a.ph_hi = N_PHASES;
    hipLaunchKernelGGL(fwd_kernel, dim3(grid), dim3(NWAVES * 64), LDS_BYTES, stream, a);
#else
    for (int p = 0; p < N_PHASES; ++p) { a.ph_lo = p; a.ph_hi = p + 1; hipLaunchKernelGGL(fwd_kernel, dim3(grid), dim3(NWAVES * 64), LDS_BYTES, stream, a); }
#endif
}
```
